# Optimizing an MI355X kernel written in HIP

```python
import math
import jax, jax.numpy as jnp
from jax import lax
import numpy as np

D_MODEL = 2048
BATCH = 4
SEQ = 4096
DEPTH = 1

MIX_WIDTH = D_MODEL
SSM_WIDTH = MIX_WIDTH // 2
POOL_WIDTH = MIX_WIDTH - SSM_WIDTH
SSM_GROUP = 16
SSM_GROUPS = SSM_WIDTH // SSM_GROUP
SSM_STATE = 64
POOL_WINDOWS = (2, 4, 8, 16)
POOL_GROUPS = len(POOL_WINDOWS)
POOL_GROUP_WIDTH = POOL_WIDTH // POOL_GROUPS
N_MEM = 256
MEM_HEADS = 4
MEM_HEAD_DIM = D_MODEL // MEM_HEADS
D_FF = ((8 * D_MODEL // 3 + 255) // 256) * 256
DT_MIN = 1e-3
DT_MAX = 1e-1
EPS = 1e-6

kernel_name = 'hymba_s5_pool_macaron_block'

F32 = jnp.float32


def rmsnorm(x, g):
    xf = x.astype(F32)
    y = xf * lax.rsqrt(jnp.mean(xf * xf, axis=-1, keepdims=True) + EPS) * g.astype(F32)
    return y.astype(x.dtype)


def swiglu(x, w_gate, w_up, w_down):
    return (jax.nn.silu(x @ w_gate) * (x @ w_up)) @ w_down


def _complex_scan_combine(e1, e2):
    a1r, a1i, b1r, b1i = e1
    a2r, a2i, b2r, b2i = e2
    ar = a2r * a1r - a2i * a1i
    ai = a2r * a1i + a2i * a1r
    br = a2r * b1r - a2i * b1i + b2r
    bi = a2r * b1i + a2i * b1r + b2i
    return (ar, ai, br, bi)


def s5_mixer(u, a_re, a_im, log_dt, b_re, b_im, c_re, c_im, d_skip, w_glu, b_glu):
    bsz, L, _ = u.shape
    uf = u.astype(F32)
    ug = uf.reshape(bsz, L, SSM_GROUPS, SSM_GROUP)
    dt = jnp.exp(log_dt.astype(F32))[:, None]
    lr, li = a_re.astype(F32), a_im.astype(F32)
    mag = jnp.exp(lr * dt)
    abar_re = mag * jnp.cos(li * dt)
    abar_im = mag * jnp.sin(li * dt)
    nr, ni = abar_re - 1.0, abar_im
    den = lr * lr + li * li
    fr = (nr * lr + ni * li) / den
    fi = (ni * lr - nr * li) / den
    br, bi = b_re.astype(F32), b_im.astype(F32)
    bbar_re = fr[..., None] * br - fi[..., None] * bi
    bbar_im = fr[..., None] * bi + fi[..., None] * br
    bu_re = jnp.einsum('blgh,gph->blgp', ug, bbar_re)
    bu_im = jnp.einsum('blgh,gph->blgp', ug, bbar_im)
    a_full_re = jnp.broadcast_to(abar_re, bu_re.shape)
    a_full_im = jnp.broadcast_to(abar_im, bu_im.shape)
    _, _, s_re, s_im = lax.associative_scan(
        _complex_scan_combine, (a_full_re, a_full_im, bu_re, bu_im), axis=1)
    y = (jnp.einsum('blgp,ghp->blgh', s_re, c_re.astype(F32))
         - jnp.einsum('blgp,ghp->blgh', s_im, c_im.astype(F32)))
    y = y.reshape(bsz, L, SSM_WIDTH) + d_skip.astype(F32) * uf
    y = jax.nn.gelu(y)
    y = y * jax.nn.sigmoid(y @ w_glu.astype(F32) + b_glu.astype(F32))
    return y.astype(u.dtype)


def pool_mixer(v, w_pool, pool_scale):
    bsz, L, _ = v.shape
    vf = v.astype(F32).reshape(bsz, L, POOL_GROUPS, POOL_GROUP_WIDTH)
    csum = jnp.cumsum(vf, axis=1)
    t = jnp.arange(L)
    pooled = []
    for gi, w in enumerate(POOL_WINDOWS):
        cg = csum[:, :, gi]
        shifted = jnp.pad(cg, ((0, 0), (w, 0), (0, 0)))[:, :L]
        cnt = jnp.minimum(t + 1, w).astype(F32)[None, :, None]
        pooled.append((cg - shifted) / cnt)
    pooled = jnp.stack(pooled, axis=2) - vf
    z = jnp.einsum('blgc,gcd->blgd', pooled, w_pool.astype(F32))
    z = z.reshape(bsz, L, POOL_WIDTH) * pool_scale.astype(F32)
    return z.astype(v.dtype)


def memory_cross_attention(h, memn, w_q, w_k, w_v, w_o):
    bsz, L, _ = h.shape
    q = (h @ w_q).reshape(bsz, L, MEM_HEADS, MEM_HEAD_DIM)
    k = (memn @ w_k).reshape(bsz, N_MEM, MEM_HEADS, MEM_HEAD_DIM)
    v = (memn @ w_v).reshape(bsz, N_MEM, MEM_HEADS, MEM_HEAD_DIM)
    s = jnp.einsum('blhd,bmhd->bhlm', q.astype(F32), k.astype(F32)) * (MEM_HEAD_DIM ** -0.5)
    p = jax.nn.softmax(s, axis=-1).astype(h.dtype)
    o = jnp.einsum('bhlm,bmhd->blhd', p, v).reshape(bsz, L, D_MODEL)
    return o @ w_o


def setup_inputs(seed: int = 0) -> dict:
    key = jax.random.key(seed)
    ks = iter(jax.random.split(key, 40))
    nrm = lambda shape, scale: jax.random.normal(next(ks), shape, F32) * scale
    gain = lambda shape: 1.0 + 0.02 * jax.random.normal(next(ks), shape, F32)
    Ly = DEPTH
    G, P, H = SSM_GROUPS, SSM_STATE, SSM_GROUP
    inp = {}
    inp['x'] = nrm((BATCH, SEQ, D_MODEL), 1.0)
    inp['mem'] = nrm((BATCH, N_MEM, D_MODEL), 1.0)
    inp['g_ffn1'] = gain((Ly, D_MODEL))
    inp['w1_gate'] = nrm((Ly, D_MODEL, D_FF), D_MODEL ** -0.5)
    inp['w1_up'] = nrm((Ly, D_MODEL, D_FF), D_MODEL ** -0.5)
    inp['w1_down'] = nrm((Ly, D_FF, D_MODEL), D_FF ** -0.5)
    inp['g_mix'] = gain((Ly, D_MODEL))
    inp['w_in'] = nrm((Ly, D_MODEL, MIX_WIDTH), D_MODEL ** -0.5)
    inp['ssm_a_re'] = -0.5 + nrm((Ly, G, P), 0.01)
    inp['ssm_a_im'] = math.pi * jnp.arange(P, dtype=F32)[None, None, :] + nrm((Ly, G, P), 0.01)
    inp['ssm_log_dt'] = jax.random.uniform(next(ks), (Ly, G), F32, math.log(DT_MIN), math.log(DT_MAX))
    inp['ssm_b_re'] = nrm((Ly, G, P, H), (2 * H) ** -0.5)
    inp['ssm_b_im'] = nrm((Ly, G, P, H), (2 * H) ** -0.5)
    inp['ssm_c_re'] = nrm((Ly, G, H, P), (2 * P) ** -0.5)
    inp['ssm_c_im'] = nrm((Ly, G, H, P), (2 * P) ** -0.5)
    inp['ssm_d'] = nrm((Ly, SSM_WIDTH), 1.0)
    inp['w_glu'] = nrm((Ly, SSM_WIDTH, SSM_WIDTH), SSM_WIDTH ** -0.5)
    inp['b_glu'] = nrm((Ly, SSM_WIDTH), 0.02)
    inp['w_pool'] = nrm((Ly, POOL_GROUPS, POOL_GROUP_WIDTH, POOL_GROUP_WIDTH), POOL_GROUP_WIDTH ** -0.5)
    inp['pool_scale'] = 1.0 + nrm((Ly, POOL_WIDTH), 0.1)
    inp['g_out_ssm'] = gain((Ly, SSM_WIDTH))
    inp['g_out_pool'] = gain((Ly, POOL_WIDTH))
    inp['w_out'] = nrm((Ly, MIX_WIDTH, D_MODEL), MIX_WIDTH ** -0.5)
    inp['g_xattn'] = gain((Ly, D_MODEL))
    inp['g_mem'] = gain((Ly, D_MODEL))
    inp['w_q'] = nrm((Ly, D_MODEL, D_MODEL), D_MODEL ** -0.5)
    inp['w_k'] = nrm((Ly, D_MODEL, D_MODEL), D_MODEL ** -0.5)
    inp['w_v'] = nrm((Ly, D_MODEL, D_MODEL), D_MODEL ** -0.5)
    inp['w_o'] = nrm((Ly, D_MODEL, D_MODEL), D_MODEL ** -0.5)
    inp['g_ffn2'] = gain((Ly, D_MODEL))
    inp['w2_gate'] = nrm((Ly, D_MODEL, D_FF), D_MODEL ** -0.5)
    inp['w2_up'] = nrm((Ly, D_MODEL, D_FF), D_MODEL ** -0.5)
    inp['w2_down'] = nrm((Ly, D_FF, D_MODEL), D_FF ** -0.5)
    inp['g_final'] = gain((D_MODEL,))
    return inp


def reference(x, mem, g_ffn1, w1_gate, w1_up, w1_down, g_mix, w_in,
              ssm_a_re, ssm_a_im, ssm_log_dt, ssm_b_re, ssm_b_im, ssm_c_re, ssm_c_im,
              ssm_d, w_glu, b_glu, w_pool, pool_scale, g_out_ssm, g_out_pool, w_out,
              g_xattn, g_mem, w_q, w_k, w_v, w_o,
              g_ffn2, w2_gate, w2_up, w2_down, g_final):
    h = x
    for l in range(DEPTH):
        h = h + 0.5 * swiglu(rmsnorm(h, g_ffn1[l]), w1_gate[l], w1_up[l], w1_down[l])
        u = rmsnorm(h, g_mix[l]) @ w_in[l]
        u_ssm, u_pool = u[..., :SSM_WIDTH], u[..., SSM_WIDTH:]
        y_ssm = s5_mixer(u_ssm, ssm_a_re[l], ssm_a_im[l], ssm_log_dt[l], ssm_b_re[l], ssm_b_im[l],
                         ssm_c_re[l], ssm_c_im[l], ssm_d[l], w_glu[l], b_glu[l])
        y_pool = pool_mixer(u_pool, w_pool[l], pool_scale[l])
        merged = jnp.concatenate([rmsnorm(y_ssm, g_out_ssm[l]), rmsnorm(y_pool, g_out_pool[l])], axis=-1)
        h = h + merged @ w_out[l]
        memn = rmsnorm(mem, g_mem[l])
        h = h + memory_cross_attention(rmsnorm(h, g_xattn[l]), memn, w_q[l], w_k[l], w_v[l], w_o[l])
        h = h + 0.5 * swiglu(rmsnorm(h, g_ffn2[l]), w2_gate[l], w2_up[l], w2_down[l])
    return rmsnorm(h, g_final)
```

```cpp
#include <hip/hip_runtime.h>
#include <hip/hip_cooperative_groups.h>
#include <cstdio>
namespace cg = cooperative_groups;

#define LAS __attribute__((address_space(3)))
typedef unsigned short bf16_t;
typedef short bf16x8 __attribute__((ext_vector_type(8)));
typedef float f32x4 __attribute__((ext_vector_type(4)));
typedef unsigned u32x4 __attribute__((ext_vector_type(4)));
typedef unsigned u32x2 __attribute__((ext_vector_type(2)));

__device__ __forceinline__ int lane_fresh() { int l; asm volatile("v_mbcnt_lo_u32_b32 %0, -1, 0\n\tv_mbcnt_hi_u32_b32 %0, -1, %0" : "=v"(l)); return l; }
__device__ __forceinline__ int opq_tid(int wid_s) { return wid_s * 64 + lane_fresh(); }
__device__ __forceinline__ float xshfl(float v, int idx4) { return __int_as_float(__builtin_amdgcn_ds_bpermute(idx4, __float_as_int(v))); }
#ifndef PROBE
#define PROBE 0
#endif
#define PROBE_IS(n) (PROBE == (n))
constexpr int T_ = 16384, D_ = 2048, FF_ = 5632;
constexpr float EPS_ = 1e-6f;
constexpr int BM = 256, BK = 64, HALF = 128, HTB = HALF * BK * 2, STAGE_BYTES = 8 * HTB, NXCD = 8, WGM = 8;
constexpr int LDS_BYTES = STAGE_BYTES + 8192 + 16;

constexpr size_t SZ_WGU = (size_t)2 * FF_ * D_ * 2, SZ_WD = (size_t)D_ * FF_ * 2, SZ_SQ = (size_t)D_ * D_ * 2;
constexpr size_t WS_W1GU = 0;
constexpr size_t WS_W1D = WS_W1GU + SZ_WGU;
constexpr size_t WS_W2GU = WS_W1D + SZ_WD;
constexpr size_t WS_W2D = WS_W2GU + SZ_WGU;
constexpr size_t WS_WIN = WS_W2D + SZ_WD;
constexpr size_t WS_WOUT = WS_WIN + SZ_SQ;
constexpr size_t WS_WQ = WS_WOUT + SZ_SQ;
constexpr size_t WS_WO = WS_WQ + SZ_SQ;
constexpr size_t WS_WKV = WS_WO + SZ_SQ;
constexpr size_t WS_WGLU = WS_WKV + 2 * SZ_SQ;
constexpr size_t WS_WP = WS_WGLU + (size_t)1024 * 1024 * 2;
constexpr size_t WS_PMAT = WS_WP + (size_t)4 * 256 * 256 * 2;
constexpr size_t WS_TQ = WS_PMAT + (size_t)64 * 128 * 256 * 2;
constexpr size_t WS_APOW = WS_TQ + (size_t)64 * 256 * 384 * 2;
constexpr size_t WS_BBAR = WS_APOW + (size_t)4096 * 17 * 8;
constexpr size_t WS_KM = WS_BBAR + (size_t)4096 * 16 * 8;
constexpr size_t WS_MEMB = WS_KM + (size_t)64 * 16 * 256 * 4;
constexpr size_t WS_KMAT = WS_MEMB + (size_t)1024 * 2048 * 2;
constexpr size_t WS_VT = WS_KMAT + (size_t)1024 * 2048 * 2;
constexpr size_t WS_HB = WS_VT + (size_t)1024 * 2048 * 2;
constexpr size_t WS_SSQ = WS_HB + (size_t)T_ * D_ * 2;
constexpr size_t WS_BAR = WS_SSQ + (size_t)8 * T_ * 4;
constexpr size_t WS_X = WS_BAR + 16384;
constexpr size_t X_ACT = 0;
constexpr size_t X_APR = 0;
constexpr size_t X_MRG = X_APR + (size_t)64 * 1024 * 384 * 2;
constexpr size_t X_APOOL = X_MRG + (size_t)T_ * 2048 * 2;
constexpr size_t X_SLOC = X_APOOL + (size_t)T_ * 1024 * 2;
constexpr size_t X_YS = X_SLOC;
constexpr size_t X_P = 0;
constexpr size_t WS_MT = WS_X + (size_t)T_ * FF_ * 2;
constexpr size_t WS_VWT = WS_MT + (size_t)16 * 256 * 2048 * 2;
constexpr size_t WS_END = WS_VWT + (size_t)4 * 2048 * 1024 * 2;
static_assert(X_SLOC + (size_t)64 * 1024 * 128 * 4 <= (size_t)T_ * FF_ * 2, "mixer scratch fits the act region");


#define XB_TMO      128
#define XB_XCNT(j)  (256  + 64 * (j))
#define XB_XSUB(j)  (1280 + 64 * (j))
#define XB_XGEN(j)  (2304 + 64 * (j))
#define XB_TOP      3328
#define XB_TOPGEN   3392
#define XCD_BAR_WORDS 3456
#define XB_SPIN_CAP (1u << 22)
__device__ __forceinline__ unsigned xb_ld(unsigned* p)              { return __hip_atomic_load(p, __ATOMIC_RELAXED, __HIP_MEMORY_SCOPE_AGENT); }
__device__ __forceinline__ unsigned xb_add(unsigned* p, unsigned v) { return __hip_atomic_fetch_add(p, v, __ATOMIC_RELAXED, __HIP_MEMORY_SCOPE_AGENT); }
__device__ __forceinline__ unsigned xb_xcc_id() { return (unsigned)__builtin_amdgcn_s_getreg((3 << 11) | 20) & 0xFu; }
#define XB_SPIN(cond, bar) do { unsigned _sp = 0; while (cond) { __builtin_amdgcn_s_sleep(1); \
    if ((++_sp & 255u) == 0u) { if (xb_ld(&(bar)[XB_TMO])) break; if (_sp > XB_SPIN_CAP) { atomicAdd(&(bar)[XB_TMO], 1u); break; } } } } while (0)
struct XcdBarrier { unsigned* bar; unsigned x; volatile LAS unsigned* st; };
__device__ __forceinline__ XcdBarrier xcd_barrier_post(const int tid, unsigned* bar, volatile LAS unsigned* st) {
    XcdBarrier b; b.bar = bar; b.x = xb_xcc_id(); b.st = st;
    if (tid == 0) (void)xb_add(&bar[XB_XCNT(b.x)], 1u);
    return b;
}
__device__ __forceinline__ void xcd_barrier_complete(unsigned* bar, unsigned x, unsigned& nloc, unsigned& nx) {
    const unsigned G = gridDim.x * gridDim.y * gridDim.z;
    unsigned sum, cnt, mine, sp = 0u;
    for (;;) {
        sum = 0u; cnt = 0u; mine = 0u;
#pragma unroll
        for (unsigned j = 0; j < 16; ++j) { const unsigned c = xb_ld(&bar[XB_XCNT(j)]); sum += c; cnt += (c > 0u) ? 1u : 0u; mine = (j == x) ? c : mine; }
        if (sum == G) break;
        __builtin_amdgcn_s_sleep(1);
        if ((++sp & 255u) == 0u) { if (xb_ld(&bar[XB_TMO])) break; if (sp > XB_SPIN_CAP) { atomicAdd(&bar[XB_TMO], 1u); break; } }
    }
    nloc = mine > 0u ? mine : 1u; nx = cnt > 0u ? cnt : 1u;
}
__device__ __forceinline__ void xcd_barrier(const int wid_s, unsigned* bar_, volatile LAS unsigned* st_) {
    const int tid0 = opq_tid(wid_s);
    XcdBarrier b; b.bar = bar_; b.st = st_; b.x = xb_xcc_id();
    asm volatile("s_waitcnt vmcnt(0)" ::: "memory");
    __syncthreads();
    if (tid0 == 0) {
        unsigned* bar = b.bar;
        __builtin_amdgcn_s_waitcnt(0);
        unsigned nloc = b.st[0], nx = b.st[1];
        if (nloc == 0u) { xcd_barrier_complete(bar, b.x, nloc, nx); b.st[0] = nloc; b.st[1] = nx; }
        const unsigned old = xb_add(&bar[XB_XSUB(b.x)], 1u);
        const unsigned gen = old / nloc;
        if (old + 1u == (gen + 1u) * nloc) {
            __builtin_amdgcn_fence(__ATOMIC_RELEASE, "agent");
            asm volatile("s_waitcnt vmcnt(0)" ::: "memory");
            const unsigned og = xb_add(&bar[XB_TOP], 1u);
            const unsigned tg = og / nx;
            if (og + 1u == (tg + 1u) * nx) xb_add(&bar[XB_TOPGEN], 1u);
            else XB_SPIN(xb_ld(&bar[XB_TOPGEN]) == tg, bar);
            __builtin_amdgcn_fence(__ATOMIC_ACQUIRE, "agent");
            xb_add(&bar[XB_XGEN(b.x)], 1u);
            asm volatile("s_waitcnt vmcnt(0)" ::: "memory");
        } else {
            XB_SPIN(xb_ld(&bar[XB_XGEN(b.x)]) == gen, bar);
            __builtin_amdgcn_fence(__ATOMIC_ACQUIRE, "agent");
            asm volatile("s_waitcnt vmcnt(0)" ::: "memory");
        }
    }
    __syncthreads();
}

struct Params { const float* in[34]; float* out; unsigned char* ws; int two; int pad; };

__device__ __forceinline__ unsigned cvt_pk_bf16(float lo, float hi) { unsigned r; asm("v_cvt_pk_bf16_f32 %0, %1, %2" : "=v"(r) : "v"(lo), "v"(hi)); return r; }
__device__ __forceinline__ u32x4 pack8(f32x4 a, f32x4 b) { u32x4 w; w.x = cvt_pk_bf16(a[0], a[1]); w.y = cvt_pk_bf16(a[2], a[3]); w.z = cvt_pk_bf16(b[0], b[1]); w.w = cvt_pk_bf16(b[2], b[3]); return w; }
__device__ __forceinline__ void unpack8(u32x4 w, f32x4& a, f32x4& b) {
    a[0] = __uint_as_float(w.x << 16); a[1] = __uint_as_float(w.x & 0xffff0000u); a[2] = __uint_as_float(w.y << 16); a[3] = __uint_as_float(w.y & 0xffff0000u);
    b[0] = __uint_as_float(w.z << 16); b[1] = __uint_as_float(w.z & 0xffff0000u); b[2] = __uint_as_float(w.w << 16); b[3] = __uint_as_float(w.w & 0xffff0000u);
}
__device__ __forceinline__ float fast_sigmoid(float x) { return __builtin_amdgcn_rcpf(1.0f + __expf(-x)); }
__device__ __forceinline__ float sum4(f32x4 v) { return (v[0] + v[1]) + (v[2] + v[3]); }
__device__ __forceinline__ float sumsq4(f32x4 v) { return (v[0] * v[0] + v[1] * v[1]) + (v[2] * v[2] + v[3] * v[3]); }
__device__ __forceinline__ float max4(f32x4 v) { return fmaxf(fmaxf(v[0], v[1]), fmaxf(v[2], v[3])); }

__device__ __forceinline__ int lds_byte(int r, int c) { const int st = (r >> 4) * 2 + (c >> 5), rr = r & 15, cc = c & 31, ob = rr * 64 + cc * 2; return st * 1024 + (ob ^ (((ob >> 9) & 1) << 5)); }
__device__ __forceinline__ void stage_rc(int b, int& R, int& C) { const int st = b / 1024, sb = b % 1024, swz = sb ^ (((sb >> 9) & 1) << 5); R = (st >> 1) * 16 + swz / 64; C = (st & 1) * 32 + (swz % 64) / 2; }
__device__ __forceinline__ int perm32(int rho) { const int n = rho >> 4, i = rho & 15; return 8 * (i >> 2) + 4 * n + (i & 3); }

struct Unit { const char* A; const char* B; int pm, pn, z, par; };

struct Order {
    const char* A; const char* B; size_t zAhi, zAlo, zBhi, zBlo, tA, tB; int nM, nN, nZ, zsh, remap, G, c;
    const char* A2; const char* B2; size_t tA2, tB2; int nM2, nN2;
    int bsh; size_t bstep;
    __device__ __forceinline__ bool next(int i, Unit& u) const {
        long L = (long)i * G + c; const int per = nM * nN; const long tot = (long)per * nZ;
        if (L < tot) {
            const int z = (int)(L / per); int wgid = (int)(L % per), pm, pn;
            if (remap) {
                const int nwg = per; { const int q = nwg / NXCD, r = nwg % NXCD, xcd = wgid % NXCD, off = wgid / NXCD; wgid = (xcd < r ? xcd * (q + 1) : r * (q + 1) + (xcd - r) * q) + off; }
                const int nig = WGM * nN, gid = wgid / nig, fm = gid * WGM, gsz = (nM - fm) < WGM ? (nM - fm) : WGM;
                pm = fm + ((wgid % nig) % gsz); pn = (wgid % nig) / gsz;
            } else { pm = wgid % nM; pn = wgid / nM; }
            const int zh = z >> zsh, zl = z & ((1 << zsh) - 1);
            u.pm = pm; u.pn = pn; u.z = z; u.A = A + zh * zAhi + zl * zAlo + pm * tA; u.B = B + zh * zBhi + zl * zBlo + pn * tB + (size_t)(pm >> bsh) * bstep; return true;
        }
        L -= tot;
        if (L < (long)nM2 * nN2) { const int pm = (int)(L % nM2), pn = (int)(L / nM2); u.pm = pm; u.pn = pn; u.z = -1; u.A = A2 + pm * tA2; u.B = B2 + pn * tB2; return true; }
        return false;
    }
};

typedef f32x4 (&AccRef)[2][2][4][2];
#define FOR_AM _Pragma("unroll") for (int ai = 0; ai < 2; ++ai) _Pragma("unroll") for (int m = 0; m < 4; ++m)
#define FOR_BJ _Pragma("unroll") for (int bj = 0; bj < 2; ++bj)

template <class Epi>
__device__ __forceinline__ void gemm_phase(const int wid_s, LAS unsigned char* lds, const int lda, const int ldb, const int K, const bool bdup, const Order& S, const Epi& E, const bool agm = false) {
    const int tid = opq_tid(wid_s), wid = wid_s, lane = tid & 63, wr = wid >> 2, wc = wid & 3, fr = lane & 15, fq = lane >> 4;
    const int nt = K / BK;
    unsigned voffA[2], voffB[2];
#pragma unroll
    for (int i = 0; i < 2; ++i) { int R, C; stage_rc(tid * 16 + i * 8192, R, C); const int Rb = (R & ~31) + perm32(R & 31);
        voffA[i] = agm ? (unsigned)((C >> 4) * (T_ * 16) + R * 16 + (C & 15)) * 2u : (unsigned)(R * lda + C) * 2u; voffB[i] = (unsigned)(Rb * ldb + C) * 2u; }
    const size_t kstep = (size_t)(BK * 2), kstepA = agm ? (size_t)4 * T_ * 32 : kstep;
    const size_t hstepA = agm ? (size_t)HALF * 32 : (size_t)HALF * lda * 2, hstepB = bdup ? (size_t)0 : (size_t)HALF * ldb * 2;
    const unsigned ldsw = (unsigned)wid * 1024u;
    const int aoff = lds_byte(wr * 64 + fr, fq * 8), boff = lds_byte(wc * 32 + fr, fq * 8);
#define PG8_SA(b, h) (((b) * 2 + (h)) * HTB)
#define PG8_SB(b, h) ((4 + (b) * 2 + (h)) * HTB)
#define PG8_STAGE(bufoff, gbase, voff) do { _Pragma("unroll") for (int _i = 0; _i < 2; ++_i) \
        __builtin_amdgcn_global_load_lds((const unsigned*)((const char*)(gbase) + (voff)[_i]), (LAS unsigned*)(lds + (bufoff) + ldsw + _i * 8192), 16, 0, 0); } while (0)
#define PG8_LDA(dst, b, h) do { _Pragma("unroll") for (int m = 0; m < 4; ++m) _Pragma("unroll") for (int k = 0; k < 2; ++k) dst[m][k] = *(const LAS bf16x8*)(lds + PG8_SA(b, h) + aoff + m * 2048 + k * 1024); } while (0)
#define PG8_LDB(dst, b, h) do { _Pragma("unroll") for (int n = 0; n < 2; ++n) _Pragma("unroll") for (int k = 0; k < 2; ++k) dst[n][k] = *(const LAS bf16x8*)(lds + PG8_SB(b, h) + boff + n * 2048 + k * 1024); } while (0)
#define PG8_MMA(ai, bj, At, Bt) do { __builtin_amdgcn_s_setprio(1); _Pragma("unroll") for (int m = 0; m < 4; ++m) _Pragma("unroll") for (int n = 0; n < 2; ++n) _Pragma("unroll") for (int k = 0; k < 2; ++k) \
        acc[ai][bj][m][n] = __builtin_amdgcn_mfma_f32_16x16x32_bf16(Bt[n][k], At[m][k], acc[ai][bj][m][n], 0, 0, 0); __builtin_amdgcn_s_setprio(0); } while (0)
#define PG8_WAIT_V(n) asm volatile("s_waitcnt vmcnt(" #n ")" ::: "memory")
#define PG8_WAIT_L(n) asm volatile("s_waitcnt lgkmcnt(" #n ")" ::: "memory")
#define PG8_BAR __builtin_amdgcn_s_barrier()
#define PG8_SCHED __builtin_amdgcn_sched_barrier(0)
    Unit cur, nxt; int ui = 0;
    if (!S.next(0, cur)) return;
    f32x4 acc[2][2][4][2];
#pragma unroll
    for (int a = 0; a < 2; ++a)
#pragma unroll
        for (int b = 0; b < 2; ++b)
#pragma unroll
            for (int m = 0; m < 4; ++m)
#pragma unroll
                for (int n = 0; n < 2; ++n) acc[a][b][m][n] = (f32x4){0.f, 0.f, 0.f, 0.f};
    bf16x8 At[4][2], B0[2][2], B1[2][2];
    const char* cA = cur.A; const char* cB = cur.B; cur.par = 0;
    if constexpr (Epi::PRE) E.prefetch(cur, tid);
    PG8_STAGE(PG8_SB(0, 0), cB, voffB); PG8_STAGE(PG8_SA(0, 0), cA, voffA); PG8_STAGE(PG8_SB(0, 1), cB + hstepB, voffB); PG8_STAGE(PG8_SA(0, 1), cA + hstepA, voffA);
    if (wr == 1) PG8_BAR;
    PG8_WAIT_V(4); PG8_BAR;
    PG8_STAGE(PG8_SB(1, 0), cB + kstep, voffB); PG8_STAGE(PG8_SA(1, 0), cA + kstepA, voffA); PG8_STAGE(PG8_SB(1, 1), cB + hstepB + kstep, voffB);
    PG8_WAIT_V(6); PG8_BAR;
    for (;;) {
        const bool has_next = S.next(ui + 1, nxt); nxt.par = (ui + 1) & 1;
        const char* nA = has_next ? nxt.A : cA; const char* nB = has_next ? nxt.B : cB;
#pragma unroll 1
        for (int t = 0; t < nt; t += 2) {
            const bool last = (t == nt - 2);
            const char* a1 = cA + (size_t)(t + 1) * kstepA;
            const char* a2 = last ? nA : cA + (size_t)(t + 2) * kstepA; const char* b2 = last ? nB : cB + (size_t)(t + 2) * kstep;
            const char* a3 = a2 + kstepA; const char* b3 = b2 + kstep;
            PG8_LDB(B0, 0, 0); PG8_SCHED; PG8_LDA(At, 0, 0); PG8_STAGE(PG8_SA(1, 1), a1 + hstepA, voffA);
            PG8_WAIT_L(8); PG8_BAR; PG8_WAIT_L(0); PG8_MMA(0, 0, At, B0); PG8_BAR; PG8_SCHED;
            PG8_LDB(B1, 0, 1); PG8_STAGE(PG8_SB(0, 0), b2, voffB);
            PG8_BAR; PG8_WAIT_L(0); PG8_MMA(0, 1, At, B1); PG8_BAR;
            PG8_LDA(At, 0, 1); PG8_STAGE(PG8_SA(0, 0), a2, voffA);
            PG8_BAR; PG8_WAIT_L(0); PG8_MMA(1, 0, At, B0); PG8_BAR; PG8_SCHED;
            PG8_STAGE(PG8_SB(0, 1), b2 + hstepB, voffB);
            PG8_WAIT_V(6); PG8_BAR; PG8_MMA(1, 1, At, B1); PG8_BAR;
            PG8_LDB(B0, 1, 0); PG8_SCHED; PG8_LDA(At, 1, 0); PG8_STAGE(PG8_SA(0, 1), a2 + hstepA, voffA);
            PG8_WAIT_L(8); PG8_BAR; PG8_WAIT_L(0); PG8_MMA(0, 0, At, B0); PG8_BAR; PG8_SCHED;
            PG8_LDB(B1, 1, 1); PG8_STAGE(PG8_SB(1, 0), b3, voffB);
            PG8_BAR; PG8_WAIT_L(0); PG8_MMA(0, 1, At, B1); PG8_BAR;
            PG8_LDA(At, 1, 1); PG8_STAGE(PG8_SA(1, 0), a3, voffA);
            PG8_BAR; PG8_WAIT_L(0); PG8_MMA(1, 0, At, B0); PG8_BAR; PG8_SCHED;
            PG8_STAGE(PG8_SB(1, 1), b3 + hstepB, voffB);
            PG8_WAIT_V(6); PG8_BAR; PG8_MMA(1, 1, At, B1); PG8_BAR;
        }
        { int fr_e = fr, fq_e = fq; asm volatile("" : "+v"(fr_e), "+v"(fq_e));
          E(acc, cur, wr, wc, fr_e, fq_e);
          if constexpr (Epi::PRE) { if (has_next) { int t_e = tid; asm volatile("" : "+v"(t_e)); E.prefetch(nxt, t_e); } } }
        if (!has_next) break;
#pragma unroll
        for (int a = 0; a < 2; ++a)
#pragma unroll
            for (int b = 0; b < 2; ++b)
#pragma unroll
                for (int m = 0; m < 4; ++m)
#pragma unroll
                    for (int n = 0; n < 2; ++n) acc[a][b][m][n] = (f32x4){0.f, 0.f, 0.f, 0.f};
        cur = nxt; cA = nA; cB = nB; ++ui;
    }
    PG8_WAIT_V(0);
    if (wr == 0) PG8_BAR;
    PG8_BAR;
#undef PG8_SA
#undef PG8_SB
#undef PG8_STAGE
#undef PG8_LDA
#undef PG8_LDB
#undef PG8_MMA
#undef PG8_WAIT_V
#undef PG8_WAIT_L
#undef PG8_BAR
#undef PG8_SCHED
}


typedef float f32x2 __attribute__((ext_vector_type(2)));
struct EpiGateUp {
    static constexpr bool MID = false, PRE = true;
    const float* ssq; bf16_t* act; LAS float* tab;
    __device__ __forceinline__ void prefetch(const Unit& u, int tid) const {
        if (tid < 256) tab[u.par * 256 + tid] = rsqrtf(ssq[u.pm * BM + tid] * (1.0f / D_) + EPS_);
    }
    __device__ __forceinline__ void operator()(AccRef acc, const Unit& u, int wr, int wc, int fr, int fq) const {
        const int colt = wc * 32 + fq * 8, row0 = u.pm * BM + wr * 64 + fr;
        const LAS float* tp = tab + u.par * 256 + wr * 64 + fr;
        for (int rep_ = 0; rep_ < (PROBE == 8 ? 2 : 1); ++rep_)
        FOR_AM { const int row = row0 + ai * HALF + m * 16; const float rs = tp[ai * HALF + m * 16]; const float c = -1.4426950408889634f * rs, rs2 = rs * rs;
            u32x4 w;
#pragma unroll
            for (int n = 0; n < 2; ++n)
#pragma unroll
                for (int h = 0; h < 2; ++h) { const f32x2 g = {acc[ai][0][m][n][2 * h], acc[ai][0][m][n][2 * h + 1]}, uu = {acc[ai][1][m][n][2 * h], acc[ai][1][m][n][2 * h + 1]};
                    const f32x2 t = g * c; f32x2 e; e.x = __builtin_amdgcn_exp2f(t.x); e.y = __builtin_amdgcn_exp2f(t.y);
                    const f32x2 d = e + 1.0f; f32x2 r; r.x = __builtin_amdgcn_rcpf(d.x); r.y = __builtin_amdgcn_rcpf(d.y);
                    const f32x2 o = (g * uu) * (r * rs2);
                    w[n * 2 + h] = cvt_pk_bf16(o.x, o.y); }
            *(u32x4*)(act + (size_t)row * FF_ + u.pn * HALF + colt) = w; }
    }
};

struct EpiKV {
    static constexpr bool MID = false, PRE = false;
    const float* ssq_m; bf16_t* kmat; bf16_t* vmat;
    __device__ __forceinline__ void operator()(AccRef acc, const Unit& u, int wr, int wc, int fr, int fq) const {
        const int colt = wc * 32 + fq * 8, row0 = u.pm * BM + wr * 64 + fr;
        bf16_t* dst = (u.pn < 8) ? kmat : vmat; const int pnl = u.pn & 7;
        float rsv[2][4];
        FOR_AM rsv[ai][m] = ssq_m[row0 + ai * HALF + m * 16];
        FOR_AM { const int row = row0 + ai * HALF + m * 16; const float rs = rsqrtf(rsv[ai][m] * (1.0f / D_) + EPS_);
            FOR_BJ *(u32x4*)(dst + (size_t)row * D_ + pnl * BM + bj * HALF + colt) = pack8(acc[ai][bj][m][0] * rs, acc[ai][bj][m][1] * rs); }
    }
};

struct EpiStore {
    static constexpr bool MID = false, PRE = false;
    bf16_t* out; int ld; float scale; int mode;
    __device__ __forceinline__ void operator()(AccRef acc, const Unit& u, int wr, int wc, int fr, int fq) const {
        const int colt = wc * 32 + fq * 8, rl0 = wr * 64 + fr;
        const int rowbase = mode ? ((u.z >> 2) * 2048 + u.pm * BM) : (u.z * 256), colbase = mode ? ((u.z & 3) * 256) : (u.pn * BM);
        FOR_AM { const int row = rowbase + rl0 + ai * HALF + m * 16;
            FOR_BJ *(u32x4*)(out + (size_t)row * ld + colbase + bj * HALF + colt) = pack8(acc[ai][bj][m][0] * scale, acc[ai][bj][m][1] * scale); }
    }
};

struct EpiResid {
    static constexpr bool MID = false, PRE = false;
    bf16_t* hb; float* ssq_out; float alpha;
    __device__ __forceinline__ void operator()(AccRef acc, const Unit& u, int wr, int wc, int fr, int fq) const {
        const int L_ = lane_fresh(), i16 = (L_ ^ 16) << 2, i32 = (L_ ^ 32) << 2;
        const int colt = wc * 32 + fq * 8, row0 = u.pm * BM + wr * 64 + fr;
        bf16_t* base = hb + (size_t)row0 * D_ + u.pn * BM + colt;
        u32x4 rr[2][4][2];
        FOR_AM { FOR_BJ rr[ai][m][bj] = *(const u32x4*)(base + (size_t)(ai * HALF + m * 16) * D_ + bj * HALF); }
        float ssv[2][4];
        FOR_AM { float ss = 0.f;
            FOR_BJ { f32x4 r0, r1; unpack8(rr[ai][m][bj], r0, r1);
                const f32x4 h0 = r0 + acc[ai][bj][m][0] * alpha, h1 = r1 + acc[ai][bj][m][1] * alpha;
                *(u32x4*)(base + (size_t)(ai * HALF + m * 16) * D_ + bj * HALF) = pack8(h0, h1); ss += sumsq4(h0) + sumsq4(h1); }
            ss += xshfl(ss, i16); ss += xshfl(ss, i32); ssv[ai][m] = ss; }
        if (fq == 0) { FOR_AM unsafeAtomicAdd(ssq_out + row0 + ai * HALF + m * 16, ssv[ai][m]); }
    }
};

struct EpiResid2 {
    static constexpr bool MID = false, PRE = false;
    bf16_t* hb; float* ssq_out; const float* ssq_s; const float* ssq_p; int zbase;
    __device__ __forceinline__ void operator()(AccRef acc, const Unit& u, int wr, int wc, int fr, int fq) const {
        const int L_ = lane_fresh(), i16 = (L_ ^ 16) << 2, i32 = (L_ ^ 32) << 2;
        const int colt = wc * 32 + fq * 8, row0 = u.pm * BM + wr * 64 + fr, half = u.z + zbase;
        const float* sq = half ? ssq_p : ssq_s;
        bf16_t* base = hb + (size_t)row0 * D_ + u.pn * BM + colt;
        float rsv[2][4]; u32x4 rr[2][4][2];
        FOR_AM rsv[ai][m] = sq[row0 + ai * HALF + m * 16];
        FOR_AM { FOR_BJ rr[ai][m][bj] = *(const u32x4*)(base + (size_t)(ai * HALF + m * 16) * D_ + bj * HALF); }
        float ssv[2][4];
        FOR_AM { const float rs = rsqrtf(rsv[ai][m] * (1.0f / 1024) + EPS_); float ss = 0.f;
            FOR_BJ { f32x4 r0, r1; unpack8(rr[ai][m][bj], r0, r1);
                const f32x4 h0 = r0 + acc[ai][bj][m][0] * rs, h1 = r1 + acc[ai][bj][m][1] * rs;
                *(u32x4*)(base + (size_t)(ai * HALF + m * 16) * D_ + bj * HALF) = pack8(h0, h1); ss += sumsq4(h0) + sumsq4(h1); }
            ss += xshfl(ss, i16); ss += xshfl(ss, i32); ssv[ai][m] = ss; }
        if (half == 1 && fq == 0) { FOR_AM unsafeAtomicAdd(ssq_out + row0 + ai * HALF + m * 16, ssv[ai][m]); }
    }
};

struct EpiWin {
    static constexpr bool MID = false, PRE = true;
    const float* ssq; bf16_t* apr; bf16_t* mrg; LAS float* tab;
    __device__ __forceinline__ void prefetch(const Unit& u, int tid) const {
        if (tid < 256) tab[u.par * 256 + tid] = rsqrtf(ssq[u.pm * BM + tid] * (1.0f / D_) + EPS_);
    }
    __device__ __forceinline__ void operator()(AccRef acc, const Unit& u, int wr, int wc, int fr, int fq) const {
        const int colt = wc * 32 + fq * 8, row0 = u.pm * BM + wr * 64 + fr;
        const LAS float* tp = tab + u.par * 256 + wr * 64 + fr;
        FOR_AM { const int row = row0 + ai * HALF + m * 16; const float rs = tp[ai * HALF + m * 16];
            FOR_BJ { const int gc = u.pn * BM + bj * HALF + colt; const u32x4 w = pack8(acc[ai][bj][m][0] * rs, acc[ai][bj][m][1] * rs);
                if (gc < 1024) { const int g = gc >> 4, h0 = gc & 15, n = row >> 4, tau = row & 15;
                    *(u32x4*)(apr + ((size_t)(g * 1024 + n)) * 384 + tau * 16 + h0) = w; }
                else *(u32x4*)(mrg + (size_t)row * D_ + gc) = w; } }
    }
};

struct EpiSloc {
    static constexpr bool MID = false, PRE = false;
    float* sloc;
    __device__ __forceinline__ void operator()(AccRef acc, const Unit& u, int wr, int wc, int fr, int fq) const {
        const int colt = wc * 32 + fq * 8, row0 = u.pm * BM + wr * 64 + fr;
        FOR_AM { const int n = row0 + ai * HALF + m * 16; float* p = sloc + ((size_t)(u.z * 1024 + n)) * 128 + colt;
            *(f32x4*)p = acc[ai][0][m][0]; *(f32x4*)(p + 4) = acc[ai][0][m][1]; }
    }
};

struct EpiY {
    static constexpr bool MID = false, PRE = false;
    const bf16_t* apr; const float* dskip; bf16_t* ys;
    __device__ __forceinline__ void operator()(AccRef acc, const Unit& u, int wr, int wc, int fr, int fq) const {
        const int colt = wc * 32 + fq * 8, row0 = u.pm * BM + wr * 64 + fr, g = u.z, ho = colt & 15;
        const f32x4 d0 = *(const f32x4*)(dskip + g * 16 + ho), d1 = *(const f32x4*)(dskip + g * 16 + ho + 4);
        u32x4 uu[2][4][2];
        FOR_AM { FOR_BJ uu[ai][m][bj] = *(const u32x4*)(apr + ((size_t)(g * 1024 + row0 + ai * HALF + m * 16)) * 384 + bj * HALF + colt); }
        FOR_AM { const int n = row0 + ai * HALF + m * 16;
            FOR_BJ { const int col = bj * HALF + colt;
                f32x4 u0, u1; unpack8(uu[ai][m][bj], u0, u1);
                f32x4 y0 = acc[ai][bj][m][0] + d0 * u0, y1 = acc[ai][bj][m][1] + d1 * u1;
#pragma unroll
                for (int j = 0; j < 4; ++j) { const float a = y0[j], b = y1[j];
                    y0[j] = a * fast_sigmoid(1.5957691216f * (a + 0.044715f * a * a * a)); y1[j] = b * fast_sigmoid(1.5957691216f * (b + 0.044715f * b * b * b)); }
                *(u32x4*)(ys + ((size_t)g * T_ + (size_t)n * 16) * 16 + col) = pack8(y0, y1); } }
    }
};

struct EpiGlu {
    static constexpr bool MID = false, PRE = false;
    const bf16_t* ys; const float* bglu; bf16_t* mrg; float* ssq_out;
    __device__ __forceinline__ void operator()(AccRef acc, const Unit& u, int wr, int wc, int fr, int fq) const {
        const int L_ = lane_fresh(), i16 = (L_ ^ 16) << 2, i32 = (L_ ^ 32) << 2;
        const int colt = wc * 32 + fq * 8, row0 = u.pm * BM + wr * 64 + fr;
        f32x4 bb[2][2];
        FOR_BJ { const int gc = u.pn * BM + bj * HALF + colt; bb[bj][0] = *(const f32x4*)(bglu + gc); bb[bj][1] = *(const f32x4*)(bglu + gc + 4); }
        u32x4 yy[2][4][2];
        FOR_AM { FOR_BJ { const int gc = u.pn * BM + bj * HALF + colt; yy[ai][m][bj] = *(const u32x4*)(ys + ((size_t)(gc >> 4) * T_ + row0 + ai * HALF + m * 16) * 16 + (gc & 15)); } }
        float ssv[2][4];
        FOR_AM { const int row = row0 + ai * HALF + m * 16; float ss = 0.f;
            FOR_BJ { const int gc = u.pn * BM + bj * HALF + colt;
                f32x4 y0, y1; unpack8(yy[ai][m][bj], y0, y1);
                f32x4 o0, o1;
#pragma unroll
                for (int j = 0; j < 4; ++j) { o0[j] = y0[j] * fast_sigmoid(acc[ai][bj][m][0][j] + bb[bj][0][j]); o1[j] = y1[j] * fast_sigmoid(acc[ai][bj][m][1][j] + bb[bj][1][j]); }
                *(u32x4*)(mrg + (size_t)row * D_ + gc) = pack8(o0, o1); ss += sumsq4(o0) + sumsq4(o1); }
            ss += xshfl(ss, i16); ss += xshfl(ss, i32); ssv[ai][m] = ss; }
        if (fq == 0) { FOR_AM unsafeAtomicAdd(ssq_out + row0 + ai * HALF + m * 16, ssv[ai][m]); }
    }
};

struct EpiPool {
    static constexpr bool MID = false, PRE = false;
    const float* pscale; bf16_t* mrg; float* ssq_out;
    __device__ __forceinline__ void operator()(AccRef acc, const Unit& u, int wr, int wc, int fr, int fq) const {
        const int L_ = lane_fresh(), i16 = (L_ ^ 16) << 2, i32 = (L_ ^ 32) << 2;
        const int colt = wc * 32 + fq * 8, row0 = u.pm * BM + wr * 64 + fr;
        f32x4 sc[2][2];
        FOR_BJ { const int pc = u.z * 256 + bj * HALF + colt; sc[bj][0] = *(const f32x4*)(pscale + pc); sc[bj][1] = *(const f32x4*)(pscale + pc + 4); }
        float ssv[2][4];
        FOR_AM { const int row = row0 + ai * HALF + m * 16; float ss = 0.f;
            FOR_BJ { const int pc = u.z * 256 + bj * HALF + colt;
                const f32x4 o0 = acc[ai][bj][m][0] * sc[bj][0], o1 = acc[ai][bj][m][1] * sc[bj][1];
                *(u32x4*)(mrg + (size_t)row * D_ + 1024 + pc) = pack8(o0, o1); ss += sumsq4(o0) + sumsq4(o1); }
            ss += xshfl(ss, i16); ss += xshfl(ss, i32); ssv[ai][m] = ss; }
        if (fq == 0) { FOR_AM unsafeAtomicAdd(ssq_out + row0 + ai * HALF + m * 16, ssv[ai][m]); }
    }
};

struct EpiSoftmax {
    static constexpr bool MID = false, PRE = false;
    const float* ssq; bf16_t* pm_; LAS float* red;
    __device__ __forceinline__ void operator()(AccRef acc, const Unit& u, int wr, int wc, int fr, int fq) const {
        const int L_ = lane_fresh(), i16 = (L_ ^ 16) << 2, i32 = (L_ ^ 32) << 2;
        const int colt = wc * 32 + fq * 8, rl0 = wr * 64 + fr, grow0 = (u.z >> 2) * 4096 + u.pm * BM, hd = u.z & 3;
        FOR_AM { const float rs = rsqrtf(ssq[grow0 + rl0 + ai * HALF + m * 16] * (1.0f / D_) + EPS_); float v = -3.0e38f;
            FOR_BJ { acc[ai][bj][m][0] *= rs; acc[ai][bj][m][1] *= rs; v = fmaxf(v, fmaxf(max4(acc[ai][bj][m][0]), max4(acc[ai][bj][m][1]))); }
            v = fmaxf(v, xshfl(v, i16)); v = fmaxf(v, xshfl(v, i32));
            if (fq == 0) red[(rl0 + ai * HALF + m * 16) * 4 + wc] = v; }
        __syncthreads();
        FOR_AM { const f32x4 r4 = *(const LAS f32x4*)(red + (rl0 + ai * HALF + m * 16) * 4); const float mx = max4(r4); float s = 0.f;
            FOR_BJ {
#pragma unroll
                for (int n = 0; n < 2; ++n)
#pragma unroll
                    for (int j = 0; j < 4; ++j) { const float e = __expf(acc[ai][bj][m][n][j] - mx); acc[ai][bj][m][n][j] = e; s += e; } }
            s += xshfl(s, i16); s += xshfl(s, i32);
            if (fq == 0) red[1024 + (rl0 + ai * HALF + m * 16) * 4 + wc] = s; }
        __syncthreads();
        FOR_AM { const int rl = rl0 + ai * HALF + m * 16; const f32x4 r4 = *(const LAS f32x4*)(red + 1024 + rl * 4); const float inv = 1.0f / sum4(r4);
            FOR_BJ *(u32x4*)(pm_ + ((size_t)(grow0 + rl)) * 1024 + hd * 256 + bj * HALF + colt) = pack8(acc[ai][bj][m][0] * inv, acc[ai][bj][m][1] * inv); }
    }
};

struct EpiNull {
    static constexpr bool MID = false, PRE = false;
    float* sink;
    __device__ __forceinline__ void operator()(AccRef acc, const Unit& u, int wr, int wc, int fr, int fq) const {
        f32x4 s = {0.f, 0.f, 0.f, 0.f};
        FOR_AM { FOR_BJ { s += acc[ai][bj][m][0]; s += acc[ai][bj][m][1]; } }
        if (sum4(s) == 12345.678f) sink[fr] = 1.0f;
    }
};

__device__ __forceinline__ void tconv_tile(const int tid, LAS unsigned char* lds, const float* W, int N, int k0, int n0, const float* gA, const float* gB, int ksplit, bf16_t* out, int ldb, int mode, int rowbase) {
    LAS unsigned* tile = (LAS unsigned*)lds;
    f32x4 v[8];
#pragma unroll
    for (int it = 0; it < 8; ++it) v[it] = *(const f32x4*)(W + (size_t)(k0 + it * 8 + (tid >> 6)) * N + n0 + (tid & 63) * 4);
#pragma unroll
    for (int it = 0; it < 8; ++it) { const int k = it * 8 + (tid >> 6), kk = k0 + k; float g = 1.0f; if (gA) g = (kk < ksplit) ? gA[kk] : gB[kk - ksplit];
        tile[k * 129 + (tid & 63) * 2] = cvt_pk_bf16(v[it][0] * g, v[it][1] * g); tile[k * 129 + (tid & 63) * 2 + 1] = cvt_pk_bf16(v[it][2] * g, v[it][3] * g); }
    __syncthreads();
    const LAS bf16_t* t16 = (const LAS bf16_t*)lds;
#pragma unroll
    for (int it = 0; it < 4; ++it) { const int c = it * 512 + tid, n = c >> 3, kc = c & 7; unsigned e[8];
#pragma unroll
        for (int i = 0; i < 8; ++i) e[i] = t16[(kc * 8 + i) * 258 + n];
        u32x4 w; w.x = e[0] | (e[1] << 16); w.y = e[2] | (e[3] << 16); w.z = e[4] | (e[5] << 16); w.w = e[6] | (e[7] << 16);
        const int nn = n0 + n; const int ro = mode ? ((nn >> 7) * 256 + (nn & 127) + rowbase) : (nn + rowbase);
        *(u32x4*)(out + (size_t)ro * ldb + k0 + kc * 8) = w; }
    __syncthreads();
}

__device__ __forceinline__ void rows_to_bf16_ssq(const int tid, const float* src, bf16_t* dst, float* ssq, int nrows) {
    const int lane = tid & 63, gw = blockIdx.x * 8 + (tid >> 6), nw = gridDim.x * 8;
    for (int row = gw; row < nrows; row += nw) { const f32x4* p = (const f32x4*)(src + (size_t)row * D_); u32x2* q = (u32x2*)(dst + (size_t)row * D_); float ss = 0.f;
        f32x4 v[8];
#pragma unroll
        for (int i = 0; i < 8; ++i) v[i] = p[lane + 64 * i];
#pragma unroll
        for (int i = 0; i < 8; ++i) { ss += sumsq4(v[i]); u32x2 w; w.x = cvt_pk_bf16(v[i][0], v[i][1]); w.y = cvt_pk_bf16(v[i][2], v[i][3]); q[lane + 64 * i] = w; }
#pragma unroll
        for (int o = 32; o > 0; o >>= 1) ss += xshfl(ss, (lane ^ o) << 2);
        if (lane == 0) ssq[row] = ss; }
}


template <int W> __device__ __forceinline__ void pooled_w(const bf16_t* mrg, bf16_t* apool, const int gi, const int gt, const int nth) {
    for (int it = gt; it < T_ * 32; it += nth) { const int c = it & 31, t = it >> 5, ch = gi * 256 + c * 8, l = t & 4095;
        const bf16_t* src = mrg + (size_t)t * D_ + 1024 + ch; u32x4 r[W];
#pragma unroll
        for (int d = 0; d < W; ++d) { r[d] = (u32x4){0u, 0u, 0u, 0u}; if (d <= l) r[d] = *(const u32x4*)(src - (size_t)d * D_); }
        f32x4 c0, c1; unpack8(r[0], c0, c1); f32x4 s0 = c0, s1 = c1;
#pragma unroll
        for (int d = 1; d < W; ++d) { f32x4 a0, a1; unpack8(r[d], a0, a1); s0 += a0; s1 += a1; }
        const int cnt = (l + 1 < W) ? (l + 1) : W; const float ic = 1.0f / (float)cnt;
        *(u32x4*)(apool + (size_t)t * 1024 + ch) = pack8(s0 * ic - c0, s1 * ic - c1); }
}

#define W1GU ((bf16_t*)(P.ws + WS_W1GU))
#define W1D ((bf16_t*)(P.ws + WS_W1D))
#define W2GU ((bf16_t*)(P.ws + WS_W2GU))
#define W2D ((bf16_t*)(P.ws + WS_W2D))
#define WIN ((bf16_t*)(P.ws + WS_WIN))
#define WOUT ((bf16_t*)(P.ws + WS_WOUT))
#define WQ ((bf16_t*)(P.ws + WS_WQ))
#define WO ((bf16_t*)(P.ws + WS_WO))
#define WKV ((bf16_t*)(P.ws + WS_WKV))
#define WGLU ((bf16_t*)(P.ws + WS_WGLU))
#define WP ((bf16_t*)(P.ws + WS_WP))
#define PMAT ((bf16_t*)(P.ws + WS_PMAT))
#define TQ ((bf16_t*)(P.ws + WS_TQ))
#define APOW ((float2*)(P.ws + WS_APOW))
#define BBAR ((float2*)(P.ws + WS_BBAR))
#define KM ((float*)(P.ws + WS_KM))
#define MEMB ((bf16_t*)(P.ws + WS_MEMB))
#define KMAT ((bf16_t*)(P.ws + WS_KMAT))
#define VT ((bf16_t*)(P.ws + WS_VT))
#define HB ((bf16_t*)(P.ws + WS_HB))
#define SSQ ((float*)(P.ws + WS_SSQ))
#define ACT ((bf16_t*)((P.ws + WS_X) + X_ACT))
#define APR ((bf16_t*)((P.ws + WS_X) + X_APR))
#define MRG ((bf16_t*)((P.ws + WS_X) + X_MRG))
#define APOOL ((bf16_t*)((P.ws + WS_X) + X_APOOL))
#define YS ((bf16_t*)((P.ws + WS_X) + X_YS))
#define SLOC ((float*)((P.ws + WS_X) + X_SLOC))
#define MT ((bf16_t*)(P.ws + WS_MT))
#define VWT ((bf16_t*)(P.ws + WS_VWT))
#define PMb ((bf16_t*)((P.ws + WS_X) + X_P))
#define ssq_x (SSQ + 0 * T_)
#define ssq_mem (SSQ + 1 * T_)
#define ssq1 (SSQ + 2 * T_)
#define ssq_ssm (SSQ + 3 * T_)
#define ssq_pool (SSQ + 4 * T_)
#define ssq2 (SSQ + 5 * T_)
#define ssq3 (SSQ + 6 * T_)
#define ssq4 (SSQ + 7 * T_)
#define HF (P.out)

__device__ __forceinline__ void tconv_job(const Params& P, const int tid, LAS unsigned char* lds, const int tI) {
    int id = tI; const float* W; int K, N, ldb, mode = 0, rowbase = 0, ksplit; const float* gA = nullptr; const float* gB = nullptr; bf16_t* out;
    if (id < 4224) { const int j = id / 704; id -= j * 704; const int l = j / 3, r = j % 3;
        if (r < 2) { W = P.in[l ? (30 + r) : (3 + r)]; K = D_; N = FF_; out = l ? W2GU : W1GU; ldb = D_; mode = 1; rowbase = r * 128; gA = P.in[l ? 29 : 2]; }
        else { W = P.in[l ? 32 : 5]; K = FF_; N = D_; out = l ? W2D : W1D; ldb = FF_; } }
    else if (id < 4224 + 1536) { id -= 4224; const int j = id >> 8; id &= 255; K = D_; N = D_; ldb = D_;
        if (j == 0) { W = P.in[7]; out = WIN; gA = P.in[6]; }
        else if (j == 1) { W = P.in[22]; out = WOUT; gA = P.in[20]; gB = P.in[21]; }
        else if (j == 2) { return; }
        else if (j == 3) { W = P.in[26]; out = WKV; gA = P.in[24]; }
        else if (j == 4) { W = P.in[27]; out = WKV + (size_t)D_ * D_; gA = P.in[24]; }
        else { W = P.in[28]; out = WO; } }
    else if (id < 4224 + 1536 + 64) { id -= 4224 + 1536; W = P.in[16]; K = 1024; N = 1024; ldb = 1024; out = WGLU; }
    else { id -= 4224 + 1536 + 64; const int gi = id >> 2; id &= 3; W = P.in[18] + (size_t)gi * 65536; K = 256; N = 256; ldb = 256; out = WP + (size_t)gi * 65536; }
    ksplit = gB ? 1024 : K;
    const int nkt = K / 64; const int kt = id % nkt, ntile = id / nkt;
    tconv_tile(tid, lds, W, N, kt * 64, ntile * 256, gA, gB, ksplit, out, ldb, mode, rowbase);
}

__global__ void __launch_bounds__(512, 2) mega(Params P) {
    extern __shared__ __attribute__((aligned(16))) unsigned char lds_raw[];
    LAS unsigned char* lds = (LAS unsigned char*)lds_raw;
    cg::grid_group grid = cg::this_grid();
    const int G = gridDim.x, bx = blockIdx.x, nth = G * 512;
    const int wid_s = __builtin_amdgcn_readfirstlane(threadIdx.x >> 6);
#define PHASE_TID const int tid = opq_tid(wid_s); const int gt = bx * 512 + tid; (void)gt
    const float* x = P.in[0];

    Order S{}; S.G = G; S.c = bx;
    unsigned* BAR = (unsigned*)(P.ws + WS_BAR);
    volatile LAS unsigned* bst = (volatile LAS unsigned*)(lds + STAGE_BYTES + 8192);
    { const int t0 = opq_tid(wid_s); if (t0 < 2) bst[t0] = 0u;
      if (bx == 0) { for (int i = t0; i < XCD_BAR_WORDS; i += 512) BAR[i] = 0u; } }

#pragma unroll 1
    for (int pass = 0; pass < P.two; ++pass) {
        PHASE_TID;
        const int nkv = (G >= 128) ? 64 : 0;
        int start, stride, hi;
        const int nt_kv = 0;
        if (pass == 0) { start = 4224 + bx; stride = G; hi = 5840; } else if (bx >= nkv) { start = bx - nkv; stride = G - nkv; hi = 4224 - nt_kv; } else { start = 4224 - nt_kv + bx; stride = nkv; hi = 4224; }
        for (int tI = start; tI < hi; tI += stride) tconv_job(P, tid, lds, tI);
        if (pass == 0) {
            rows_to_bf16_ssq(tid, x, HB, ssq_x, T_);
            rows_to_bf16_ssq(tid, P.in[1], MEMB, ssq_mem, 1024);
            for (int i = gt; i < 6 * T_; i += nth) ssq1[i] = 0.f;
            for (int i = gt; i < D_ * D_ / 8; i += nth) { const int c = i >> 8; const float g = P.in[23][c]; const f32x4 a = *(const f32x4*)(P.in[25] + (size_t)i * 8), b = *(const f32x4*)(P.in[25] + (size_t)i * 8 + 4);
                *(u32x4*)(WQ + (size_t)i * 8) = pack8(a * g, b * g); }
            for (int item = gt; item < 4096 * 17; item += nth) {
                const int idx = item / 17, k = item - idx * 17, g = idx >> 6; const double dt = exp((double)P.in[10][g]); const float lr = P.in[8][idx], li = P.in[9][idx];
                const double xk = (double)lr * dt * k; double rev = (double)li * dt * k * 0.15915494309189535; rev -= rint(rev);
                const float a = (float)(rev * 6.283185307179586), xf = (float)xk; const float mag = expf(xf), cs = cosf(a), sn = sinf(a);
                APOW[item] = make_float2(mag * cs, mag * sn);
                if (k == 1) { const float a1i = mag * sn; const float sh = sinf(0.5f * a); const float nr1 = expm1f(xf) * cs - 2.0f * sh * sh;
                    const float den = lr * lr + li * li, fr_ = (nr1 * lr + a1i * li) / den, fi_ = (a1i * lr - nr1 * li) / den;
#pragma unroll 4
                    for (int h = 0; h < 16; ++h) { const float br = P.in[11][idx * 16 + h], bi = P.in[12][idx * 16 + h]; BBAR[idx * 16 + h] = make_float2(fr_ * br - fi_ * bi, fr_ * bi + fi_ * br); } }
            }
            grid.sync();
            (void)xcd_barrier_post(opq_tid(wid_s), BAR, bst);
        } else {
            if (bx < nkv || nkv == 0) {
                Order SK{}; SK.G = nkv ? nkv : G; SK.c = bx; SK.A = (const char*)MEMB; SK.B = (const char*)WKV; SK.tA = SK.tB = (size_t)BM * D_ * 2; SK.nM = 4; SK.nN = 16; SK.nZ = 1;
                EpiKV E{ssq_mem, KMAT, VT};
                gemm_phase(wid_s, lds, D_, D_, D_, false, SK, E);
            }
            xcd_barrier(wid_s, (unsigned*)(P.ws + WS_BAR), (volatile LAS unsigned*)(lds + STAGE_BYTES + 8192));
        }
    }
    if (PROBE == 3) { for (int r = 0; r < 10; ++r) xcd_barrier(wid_s, (unsigned*)(P.ws + WS_BAR), (volatile LAS unsigned*)(lds + STAGE_BYTES + 8192)); }
    {
        PHASE_TID;
        const float* c_re = P.in[13]; const float* c_im = P.in[14];
        for (int it = gt; it < 64 * 16 * 256; it += nth) { const int hi = it & 15, ho = (it >> 4) & 15, dl = (it >> 8) & 15, g = it >> 12; float s = 0.f;
            for (int p = 0; p < 64; ++p) { const float2 a = APOW[(g * 64 + p) * 17 + dl], b = BBAR[(g * 64 + p) * 16 + hi]; const float wr_ = a.x * b.x - a.y * b.y, wi_ = a.x * b.y + a.y * b.x;
                s += c_re[(g * 16 + ho) * 64 + p] * wr_ - c_im[(g * 16 + ho) * 64 + p] * wi_; }
            KM[it] = s; }
        for (int it = gt; it < 64 * 128 * 32; it += nth) { const int kc = it & 31, row = (it >> 5) & 127, g = it >> 12, p = row & 63, im = row >> 6, tau = kc >> 1, h0 = (kc & 1) * 8;
            const float2 a = APOW[(g * 64 + p) * 17 + 15 - tau]; f32x4 v0, v1;
#pragma unroll
            for (int e = 0; e < 8; ++e) { const float2 b = BBAR[(g * 64 + p) * 16 + h0 + e]; const float v = im ? (a.x * b.y + a.y * b.x) : (a.x * b.x - a.y * b.y); if (e < 4) v0[e] = v; else v1[e - 4] = v; }
            *(u32x4*)(PMAT + ((size_t)(g * 128 + row)) * 256 + kc * 8) = pack8(v0, v1); }
        for (int it = gt; it < 64 * 256 * 16; it += nth) { const int pc = it & 15, r = (it >> 4) & 255, g = it >> 12, tp = r >> 4, ho = r & 15, im = pc >> 3, p0 = (pc & 7) * 8; f32x4 v0, v1;
#pragma unroll
            for (int e = 0; e < 8; ++e) { const int p = p0 + e; const float2 a = APOW[(g * 64 + p) * 17 + tp + 1]; const float cr = c_re[(g * 16 + ho) * 64 + p], ci = c_im[(g * 16 + ho) * 64 + p];
                const float v = im ? -(cr * a.y + ci * a.x) : (cr * a.x - ci * a.y); if (e < 4) v0[e] = v; else v1[e - 4] = v; }
            *(u32x4*)(TQ + ((size_t)(g * 256 + r)) * 384 + 256 + pc * 8) = pack8(v0, v1); }
        __syncthreads();
        {
            const bool split = (G >= 256);
            for (int job = 0; job < 2; ++job) {
                if (split && ((bx >= 128) != (job == 1))) continue;
                Order SA{}; SA.G = split ? 128 : G; SA.c = split ? (bx & 127) : bx; SA.zsh = 2; SA.nZ = 16;
                if (job == 0) { SA.A = (const char*)KMAT; SA.zAhi = (size_t)256 * D_ * 2; SA.zAlo = 1024; SA.tA = 0; SA.B = (const char*)WQ; SA.zBhi = 0; SA.zBlo = 1024; SA.tB = (size_t)BM * D_ * 2; SA.nM = 1; SA.nN = 8; }
                else { SA.A = (const char*)WO; SA.zAhi = 0; SA.zAlo = 1024; SA.tA = (size_t)BM * D_ * 2; SA.B = (const char*)VT; SA.zBhi = (size_t)256 * D_ * 2; SA.zBlo = 1024; SA.tB = 0; SA.nM = 8; SA.nN = 1; }
                EpiStore EA{job ? VWT : MT, job ? 1024 : D_, job ? 1.0f : 0.044194173824159216f, job};
                gemm_phase(wid_s, lds, D_, D_, 512, false, SA, EA);
            }
        }
        S.A = (const char*)HB; S.B = (const char*)W1GU; S.zAhi = S.zAlo = S.zBhi = S.zBlo = 0; S.tA = (size_t)BM * D_ * 2; S.tB = (size_t)BM * D_ * 2; S.nM = 64; S.nN = 44; S.nZ = 1; S.zsh = 0; S.remap = 1;
        EpiGateUp E{ssq_x, ACT, (LAS float*)(lds + STAGE_BYTES)};
        gemm_phase(wid_s, lds, D_, D_, D_, false, S, E);
    }
    xcd_barrier(wid_s, (unsigned*)(P.ws + WS_BAR), (volatile LAS unsigned*)(lds + STAGE_BYTES + 8192));

    {
        PHASE_TID;
        for (int it = gt; it < 64 * 256 * 32; it += nth) { const int kc = it & 31, r = (it >> 5) & 255, g = it >> 13, tau = kc >> 1, hi0 = (kc & 1) * 8, tp = r >> 4, ho = r & 15;
            f32x4 v0 = {0.f, 0.f, 0.f, 0.f}, v1 = {0.f, 0.f, 0.f, 0.f};
            if (tp >= tau) { const float* kp = KM + ((g * 16 + tp - tau) * 16 + ho) * 16 + hi0; v0 = *(const f32x4*)kp; v1 = *(const f32x4*)(kp + 4); }
            *(u32x4*)(TQ + ((size_t)(g * 256 + r)) * 384 + kc * 8) = pack8(v0, v1); }
        __syncthreads();
        S.A = (const char*)ACT; S.B = (const char*)W1D; S.tA = (size_t)BM * FF_ * 2; S.tB = (size_t)BM * FF_ * 2; S.nM = 64; S.nN = 8; S.nZ = 1; S.remap = 1;
        EpiResid E{HB, ssq1, 0.5f};
        gemm_phase(wid_s, lds, FF_, FF_, FF_, false, S, E);
    }
    xcd_barrier(wid_s, (unsigned*)(P.ws + WS_BAR), (volatile LAS unsigned*)(lds + STAGE_BYTES + 8192));

    {
        S.A = (const char*)HB; S.B = (const char*)WIN; S.tA = S.tB = (size_t)BM * D_ * 2; S.nM = 64; S.nN = 8;
        EpiWin E{ssq1, APR, MRG, (LAS float*)(lds + STAGE_BYTES)};
        gemm_phase(wid_s, lds, D_, D_, D_, false, S, E);
    }
    xcd_barrier(wid_s, (unsigned*)(P.ws + WS_BAR), (volatile LAS unsigned*)(lds + STAGE_BYTES + 8192));

    {
        S.A = (const char*)APR; S.B = (const char*)PMAT; S.zAhi = (size_t)1024 * 384 * 2; S.zBhi = (size_t)128 * 256 * 2; S.tA = (size_t)BM * 384 * 2; S.tB = 0; S.nM = 4; S.nN = 1; S.nZ = 64; S.remap = 0;
        EpiSloc E{SLOC};
        gemm_phase(wid_s, lds, 384, 256, 256, true, S, E);
        if (G == 256) { __builtin_amdgcn_fence(__ATOMIC_ACQUIRE, "agent"); asm volatile("s_waitcnt vmcnt(0)" ::: "memory"); __syncthreads(); }
        else xcd_barrier(wid_s, (unsigned*)(P.ws + WS_BAR), (volatile LAS unsigned*)(lds + STAGE_BYTES + 8192));
        PHASE_TID;
        const int wid = tid >> 6, p = tid & 63; LAS float* endst = (LAS float*)(lds + STAGE_BYTES);
        for (int pair = bx; pair < 256; pair += G) { const int b = pair & 3, g = pair >> 2;
            const float2 a = APOW[(g * 64 + p) * 17 + 16];
            const float* sl = SLOC + ((size_t)(g * 1024 + b * 256 + wid * 32)) * 128;
            float xr[32], xi[32];
#pragma unroll
            for (int k = 0; k < 32; ++k) { xr[k] = sl[k * 128 + p]; xi[k] = sl[k * 128 + 64 + p]; }
            float sr = 0.f, si = 0.f;
#pragma unroll
            for (int k = 0; k < 32; ++k) { const float n_ = a.x * sr - a.y * si + xr[k]; si = a.x * si + a.y * sr + xi[k]; sr = n_; }
            float pr = a.x, pi = a.y;
#pragma unroll
            for (int q = 0; q < 5; ++q) { const float n_ = pr * pr - pi * pi; pi = 2.f * pr * pi; pr = n_; }
            endst[wid * 64 + p] = sr; endst[512 + wid * 64 + p] = si;
            __syncthreads();
            float cr = 0.f, ci = 0.f;
            for (int j = 0; j < wid; ++j) { const float ex = endst[j * 64 + p], ey = endst[512 + j * 64 + p]; const float n_ = pr * cr - pi * ci + ex; ci = pr * ci + pi * cr + ey; cr = n_; }
            bf16_t* ap = APR + ((size_t)(g * 1024 + b * 256 + wid * 32)) * 384 + 256;
            sr = cr; si = ci;
#pragma unroll
            for (int k = 0; k < 32; ++k) { const unsigned w = cvt_pk_bf16(sr, si); ap[k * 384 + p] = (bf16_t)(w & 0xffffu); ap[k * 384 + 64 + p] = (bf16_t)(w >> 16);
                const float n_ = a.x * sr - a.y * si + xr[k]; si = a.x * si + a.y * sr + xi[k]; sr = n_; }
            __syncthreads();
        }
        pooled_w<2>(MRG, APOOL, 0, gt, nth); pooled_w<4>(MRG, APOOL, 1, gt, nth); pooled_w<8>(MRG, APOOL, 2, gt, nth); pooled_w<16>(MRG, APOOL, 3, gt, nth);
    }
    xcd_barrier(wid_s, (unsigned*)(P.ws + WS_BAR), (volatile LAS unsigned*)(lds + STAGE_BYTES + 8192));

    {
        {
            S.A = (const char*)APR; S.B = (const char*)TQ; S.zAhi = (size_t)1024 * 384 * 2; S.zBhi = (size_t)256 * 384 * 2; S.tA = (size_t)BM * 384 * 2; S.tB = 0; S.nM = 4; S.nN = 1; S.nZ = 64; S.remap = 0;
            EpiY E{APR, P.in[15], YS};
            gemm_phase(wid_s, lds, 384, 384, 384, false, S, E);
        }
        {
            S.A = (const char*)APOOL; S.B = (const char*)WP; S.zAhi = 256 * 2; S.zBhi = (size_t)256 * 256 * 2; S.tA = (size_t)BM * 1024 * 2; S.tB = 0; S.nM = 64; S.nN = 1; S.nZ = 4; S.remap = 0;
            EpiPool E{P.in[19], MRG, ssq_pool};
            gemm_phase(wid_s, lds, 1024, 256, 256, false, S, E);
        }
    }
    xcd_barrier(wid_s, (unsigned*)(P.ws + WS_BAR), (volatile LAS unsigned*)(lds + STAGE_BYTES + 8192));

    {
        S.A = (const char*)YS; S.B = (const char*)WGLU; S.zAhi = S.zBhi = 0; S.tA = (size_t)BM * 32; S.tB = (size_t)BM * 1024 * 2; S.nM = 64; S.nN = 4; S.nZ = 1; S.remap = 1;
        EpiGlu E{YS, P.in[17], MRG, ssq_ssm};
        gemm_phase(wid_s, lds, 1024, 1024, 1024, false, S, E, true);
    }
    xcd_barrier(wid_s, (unsigned*)(P.ws + WS_BAR), (volatile LAS unsigned*)(lds + STAGE_BYTES + 8192));

    {
        const bool fuse2 = (512 % G) == 0;
        const int ncall = fuse2 ? 1 : P.two;
#pragma unroll 1
        for (int zz = 0; zz < ncall; ++zz) {
            S.A = (const char*)(MRG + (fuse2 ? 0 : zz * 1024)); S.B = (const char*)(WOUT + (fuse2 ? 0 : zz * 1024)); S.tA = S.tB = (size_t)BM * D_ * 2; S.nM = 64; S.nN = 8;
            S.nZ = fuse2 ? 2 : 1; S.zsh = 0; S.zAhi = 1024 * 2; S.zBhi = 1024 * 2; S.zAlo = S.zBlo = 0; S.remap = 1;
            EpiResid2 E{HB, ssq2, ssq_ssm, ssq_pool, fuse2 ? 0 : zz};
            gemm_phase(wid_s, lds, D_, D_, 1024, false, S, E);
            if (!fuse2 && zz == 0) xcd_barrier(wid_s, (unsigned*)(P.ws + WS_BAR), (volatile LAS unsigned*)(lds + STAGE_BYTES + 8192));
        }
        S.nZ = 1; S.zAhi = S.zBhi = 0;
    }
    xcd_barrier(wid_s, (unsigned*)(P.ws + WS_BAR), (volatile LAS unsigned*)(lds + STAGE_BYTES + 8192));

    {
        S.A = (const char*)HB; S.B = (const char*)MT; S.zsh = 2; S.zAhi = (size_t)4096 * D_ * 2; S.zAlo = 0; S.zBhi = (size_t)4 * 256 * D_ * 2; S.zBlo = (size_t)256 * D_ * 2; S.tA = (size_t)BM * D_ * 2; S.tB = 0; S.nM = 16; S.nN = 1; S.nZ = 16; S.remap = 0;
        EpiSoftmax E{ssq2, PMb, (LAS float*)(lds + STAGE_BYTES)};
        gemm_phase(wid_s, lds, D_, D_, D_, false, S, E);
    }
    xcd_barrier(wid_s, (unsigned*)(P.ws + WS_BAR), (volatile LAS unsigned*)(lds + STAGE_BYTES + 8192));

    {
        S.A = (const char*)PMb; S.B = (const char*)VWT; S.zsh = 0; S.zAhi = S.zAlo = S.zBhi = S.zBlo = 0; S.tA = (size_t)BM * 1024 * 2; S.tB = (size_t)BM * 1024 * 2; S.nM = 64; S.nN = 8; S.nZ = 1; S.remap = 1; S.bsh = 4; S.bstep = (size_t)2048 * 1024 * 2;
        EpiResid E{HB, ssq3, 1.0f};
        gemm_phase(wid_s, lds, 1024, 1024, 1024, false, S, E);
        S.bstep = 0; S.bsh = 0;
    }
    xcd_barrier(wid_s, (unsigned*)(P.ws + WS_BAR), (volatile LAS unsigned*)(lds + STAGE_BYTES + 8192));

    {
        S.A = (const char*)HB; S.B = (const char*)W2GU; S.tA = S.tB = (size_t)BM * D_ * 2; S.nM = 64; S.nN = 44;
        EpiGateUp E{ssq3, ACT, (LAS float*)(lds + STAGE_BYTES)};
        gemm_phase(wid_s, lds, D_, D_, D_, false, S, E);
        if (PROBE == 1) { xcd_barrier(wid_s, (unsigned*)(P.ws + WS_BAR), (volatile LAS unsigned*)(lds + STAGE_BYTES + 8192)); gemm_phase(wid_s, lds, D_, D_, D_, false, S, E); }
        if (PROBE == 5) {
            f32x4 pacc[32]; bf16x8 pa, pb;
#pragma unroll
            for (int i = 0; i < 32; ++i) pacc[i] = (f32x4){0.f, 0.f, 0.f, 0.f};
            { const int t9 = opq_tid(wid_s); const short v9 = (short)(0x3c00 + (t9 & 127));
#pragma unroll
              for (int i = 0; i < 8; ++i) { pa[i] = (short)(v9 + i * 3); pb[i] = (short)(v9 ^ (i * 5)); } }
#pragma unroll 1
            for (int it9 = 0; it9 < 11 * 32; ++it9) {
                __builtin_amdgcn_s_setprio(1);
#pragma unroll
                for (int r9 = 0; r9 < 2; ++r9)
#pragma unroll
                    for (int i = 0; i < 32; ++i) pacc[i] = __builtin_amdgcn_mfma_f32_16x16x32_bf16(pa, pb, pacc[i], 0, 0, 0);
                __builtin_amdgcn_s_setprio(0);
            }
            f32x4 s9 = {0.f, 0.f, 0.f, 0.f};
#pragma unroll
            for (int i = 0; i < 32; ++i) s9 += pacc[i];
            if (sum4(s9) == 12345.678f) ((float*)(P.ws + WS_KM))[0] = 1.0f;
        }
        if (PROBE == 9) { xcd_barrier(wid_s, (unsigned*)(P.ws + WS_BAR), (volatile LAS unsigned*)(lds + STAGE_BYTES + 8192)); Order S9 = S; EpiNull E9{(float*)(P.ws + WS_KM)}; gemm_phase(wid_s, lds, D_, D_, D_, false, S9, E9); }
        if (PROBE == 7) { xcd_barrier(wid_s, (unsigned*)(P.ws + WS_BAR), (volatile LAS unsigned*)(lds + STAGE_BYTES + 8192)); Order S9 = S; S9.tA = S9.tB = (size_t)BM * (D_ + 64) * 2; EpiNull E9{(float*)(P.ws + WS_KM)}; gemm_phase(wid_s, lds, D_ + 64, D_ + 64, D_, false, S9, E9); }
    }
    xcd_barrier(wid_s, (unsigned*)(P.ws + WS_BAR), (volatile LAS unsigned*)(lds + STAGE_BYTES + 8192));

    {
        S.A = (const char*)ACT; S.B = (const char*)W2D; S.tA = S.tB = (size_t)BM * FF_ * 2; S.nM = 64; S.nN = 8;
        EpiResid E{HB, ssq4, 0.5f};
        gemm_phase(wid_s, lds, FF_, FF_, FF_, false, S, E);
    }
    xcd_barrier(wid_s, (unsigned*)(P.ws + WS_BAR), (volatile LAS unsigned*)(lds + STAGE_BYTES + 8192));

    {
        PHASE_TID;
        const int lane = tid & 63, gw = bx * 8 + (tid >> 6), nw = G * 8; const f32x4* gf = (const f32x4*)P.in[33];
        for (int row = gw; row < T_; row += 2 * nw) {
            const bool has2 = (row + nw < T_); const int row2 = has2 ? row + nw : row;
            const float rs = rsqrtf(ssq4[row] * (1.0f / D_) + EPS_), rs2 = rsqrtf(ssq4[row2] * (1.0f / D_) + EPS_);
            const u32x4* hp = (const u32x4*)(HB + (size_t)row * D_); const u32x4* hp2 = (const u32x4*)(HB + (size_t)row2 * D_);
            f32x4* p = (f32x4*)(P.out + (size_t)row * D_); f32x4* p2 = (f32x4*)(P.out + (size_t)row2 * D_);
            u32x4 w[4], w2[4];
#pragma unroll
            for (int i = 0; i < 4; ++i) { w[i] = hp[lane + 64 * i]; w2[i] = hp2[lane + 64 * i]; }
#pragma unroll
            for (int i = 0; i < 4; ++i) { f32x4 a, b; const int c4 = (lane + 64 * i) * 2; const f32x4 g0 = gf[c4], g1 = gf[c4 + 1];
                unpack8(w[i], a, b); p[c4] = a * rs * g0; p[c4 + 1] = b * rs * g1;
                unpack8(w2[i], a, b); if (has2) { p2[c4] = a * rs2 * g0; p2[c4 + 1] = b * rs2 * g1; } } }
    }
}

extern "C" void kernel_launch(void* const* d_in, const int* in_sizes, int n_in, void* d_out, int out_size, void* d_ws, size_t ws_size, hipStream_t stream) {
    static int grid_blocks = 0;
    if (!grid_blocks) {
        if (n_in != 34 || out_size != T_ * D_ || ws_size < WS_END) { fprintf(stderr, "kernel_launch: unexpected shapes (n_in %d out %d ws %zu need %zu)\n", n_in, out_size, ws_size, (size_t)WS_END); grid_blocks = -1; return; }
        int dev = 0, cus = 0, per_cu = 0;
        (void)hipGetDevice(&dev);
        (void)hipDeviceGetAttribute(&cus, hipDeviceAttributeMultiprocessorCount, dev);
        if (hipFuncSetAttribute((const void*)mega, hipFuncAttributeMaxDynamicSharedMemorySize, LDS_BYTES) != hipSuccess) { fprintf(stderr, "hipFuncSetAttribute failed\n"); grid_blocks = -1; return; }
        (void)hipOccupancyMaxActiveBlocksPerMultiprocessor(&per_cu, (const void*)mega, 512, LDS_BYTES);
        if (per_cu < 1) per_cu = 1;
        grid_blocks = cus * per_cu;
    }
    if (grid_blocks < 0) return;
    Params p{};
    for (int i = 0; i < 34; ++i) p.in[i] = (const float*)d_in[i];
    p.out = (float*)d_out; p.ws = (unsigned char*)d_ws; p.two = 2; p.pad = 0;
    void* args[] = {&p};
    hipError_t e = hipLaunchCooperativeKernel((const void*)mega, dim3(grid_blocks), dim3(512), args, LDS_BYTES, stream);
    if (e != hipSuccess) fprintf(stderr, "cooperative launch failed: %s (grid %d)\n", hipGetErrorString(e), grid_blocks);
}
```

```cpp
#include <hip/hip_runtime.h>
#include <hip/hip_cooperative_groups.h>
#include <cstdio>
namespace cg = cooperative_groups;

#define LAS __attribute__((address_space(3)))
typedef unsigned short bf16_t;
typedef short bf16x8 __attribute__((ext_vector_type(8)));
typedef float f32x4 __attribute__((ext_vector_type(4)));
typedef unsigned u32x4 __attribute__((ext_vector_type(4)));
typedef unsigned u32x2 __attribute__((ext_vector_type(2)));

__device__ __forceinline__ int lane_fresh() { int l; asm volatile("v_mbcnt_lo_u32_b32 %0, -1, 0\n\tv_mbcnt_hi_u32_b32 %0, -1, %0" : "=v"(l)); return l; }
__device__ __forceinline__ int opq_tid(int wid_s) { return wid_s * 64 + lane_fresh(); }
__device__ __forceinline__ float xshfl(float v, int idx4) { return __int_as_float(__builtin_amdgcn_ds_bpermute(idx4, __float_as_int(v))); }
#ifndef PROBE
#define PROBE 0
#endif
#define PROBE_IS(n) (PROBE == (n))
constexpr int T_ = 16384, D_ = 2048, FF_ = 5632;
constexpr float EPS_ = 1e-6f;
constexpr int BM = 256, BK = 64, HALF = 128, HTB = HALF * BK * 2, STAGE_BYTES = 8 * HTB, NXCD = 8, WGM = 8;
constexpr int LDS_BYTES = STAGE_BYTES + 8192 + 16;

constexpr size_t SZ_WGU = (size_t)2 * FF_ * D_ * 2, SZ_WD = (size_t)D_ * FF_ * 2, SZ_SQ = (size_t)D_ * D_ * 2;
constexpr size_t WS_W1GU = 0;
constexpr size_t WS_W1D = WS_W1GU + SZ_WGU;
constexpr size_t WS_W2GU = WS_W1D + SZ_WD;
constexpr size_t WS_W2D = WS_W2GU + SZ_WGU;
constexpr size_t WS_WIN = WS_W2D + SZ_WD;
constexpr size_t WS_WOUT = WS_WIN + SZ_SQ;
constexpr size_t WS_WQ = WS_WOUT + SZ_SQ;
constexpr size_t WS_WO = WS_WQ + SZ_SQ;
constexpr size_t WS_WKV = WS_WO + SZ_SQ;
constexpr size_t WS_WGLU = WS_WKV + 2 * SZ_SQ;
constexpr size_t WS_WP = WS_WGLU + (size_t)1024 * 1024 * 2;
constexpr size_t WS_PMAT = WS_WP + (size_t)4 * 256 * 256 * 2;
constexpr size_t WS_TQ = WS_PMAT + (size_t)64 * 128 * 256 * 2;
constexpr size_t WS_APOW = WS_TQ + (size_t)64 * 256 * 384 * 2;
constexpr size_t WS_BBAR = WS_APOW + (size_t)4096 * 17 * 8;
constexpr size_t WS_KM = WS_BBAR + (size_t)4096 * 16 * 8;
constexpr size_t WS_MEMB = WS_KM + (size_t)64 * 16 * 256 * 4;
constexpr size_t WS_KMAT = WS_MEMB + (size_t)1024 * 2048 * 2;
constexpr size_t WS_VT = WS_KMAT + (size_t)1024 * 2048 * 2;
constexpr size_t WS_HB = WS_VT + (size_t)1024 * 2048 * 2;
constexpr size_t WS_SSQ = WS_HB + (size_t)T_ * D_ * 2;
constexpr size_t WS_BAR = WS_SSQ + (size_t)8 * T_ * 4;
constexpr size_t WS_X = WS_BAR + 16384;
constexpr size_t X_ACT = 0;
constexpr size_t X_APR = 0;
constexpr size_t X_MRG = X_APR + (size_t)64 * 1024 * 384 * 2;
constexpr size_t X_APOOL = X_MRG + (size_t)T_ * 2048 * 2;
constexpr size_t X_SLOC = X_APOOL + (size_t)T_ * 1024 * 2;
constexpr size_t X_YS = X_SLOC;
constexpr size_t X_P = 0;
constexpr size_t WS_MT = WS_X + (size_t)T_ * FF_ * 2;
constexpr size_t WS_VWT = WS_MT + (size_t)16 * 256 * 2048 * 2;
constexpr size_t WS_END = WS_VWT + (size_t)4 * 2048 * 1024 * 2;
static_assert(X_SLOC + (size_t)64 * 1024 * 128 * 4 <= (size_t)T_ * FF_ * 2, "mixer scratch fits the act region");


#define XB_TMO      128
#define XB_XCNT(j)  (256  + 64 * (j))
#define XB_XSUB(j)  (1280 + 64 * (j))
#define XB_XGEN(j)  (2304 + 64 * (j))
#define XB_TOP      3328
#define XB_TOPGEN   3392
#define XCD_BAR_WORDS 3456
#define XB_SPIN_CAP (1u << 22)
__device__ __forceinline__ unsigned xb_ld(unsigned* p)              { return __hip_atomic_load(p, __ATOMIC_RELAXED, __HIP_MEMORY_SCOPE_AGENT); }
__device__ __forceinline__ unsigned xb_add(unsigned* p, unsigned v) { return __hip_atomic_fetch_add(p, v, __ATOMIC_RELAXED, __HIP_MEMORY_SCOPE_AGENT); }
__device__ __forceinline__ unsigned xb_xcc_id() { return (unsigned)__builtin_amdgcn_s_getreg((3 << 11) | 20) & 0xFu; }
#define XB_SPIN(cond, bar) do { unsigned _sp = 0; while (cond) { __builtin_amdgcn_s_sleep(1); \
    if ((++_sp & 255u) == 0u) { if (xb_ld(&(bar)[XB_TMO])) break; if (_sp > XB_SPIN_CAP) { atomicAdd(&(bar)[XB_TMO], 1u); break; } } } } while (0)
struct XcdBarrier { unsigned* bar; unsigned x; volatile LAS unsigned* st; };
__device__ __forceinline__ XcdBarrier xcd_barrier_post(const int tid, unsigned* bar, volatile LAS unsigned* st) {
    XcdBarrier b; b.bar = bar; b.x = xb_xcc_id(); b.st = st;
    if (tid == 0) (void)xb_add(&bar[XB_XCNT(b.x)], 1u);
    return b;
}
__device__ __forceinline__ void xcd_barrier_complete(unsigned* bar, unsigned x, unsigned& nloc, unsigned& nx) {
    const unsigned G = gridDim.x * gridDim.y * gridDim.z;
    unsigned sum, cnt, mine, sp = 0u;
    for (;;) {
        sum = 0u; cnt = 0u; mine = 0u;
#pragma unroll
        for (unsigned j = 0; j < 16; ++j) { const unsigned c = xb_ld(&bar[XB_XCNT(j)]); sum += c; cnt += (c > 0u) ? 1u : 0u; mine = (j == x) ? c : mine; }
        if (sum == G) break;
        __builtin_amdgcn_s_sleep(1);
        if ((++sp & 255u) == 0u) { if (xb_ld(&bar[XB_TMO])) break; if (sp > XB_SPIN_CAP) { atomicAdd(&bar[XB_TMO], 1u); break; } }
    }
    nloc = mine > 0u ? mine : 1u; nx = cnt > 0u ? cnt : 1u;
}
__device__ __forceinline__ void xcd_barrier(const int wid_s, unsigned* bar_, volatile LAS unsigned* st_) {
    const int tid0 = opq_tid(wid_s);
    XcdBarrier b; b.bar = bar_; b.st = st_; b.x = xb_xcc_id();
    asm volatile("s_waitcnt vmcnt(0)" ::: "memory");
    __syncthreads();
    if (tid0 == 0) {
        unsigned* bar = b.bar;
        __builtin_amdgcn_s_waitcnt(0);
        unsigned nloc = b.st[0], nx = b.st[1];
        if (nloc == 0u) { xcd_barrier_complete(bar, b.x, nloc, nx); b.st[0] = nloc; b.st[1] = nx; }
        const unsigned old = xb_add(&bar[XB_XSUB(b.x)], 1u);
        const unsigned gen = old / nloc;
        if (old + 1u == (gen + 1u) * nloc) {
            __builtin_amdgcn_fence(__ATOMIC_RELEASE, "agent");
            asm volatile("s_waitcnt vmcnt(0)" ::: "memory");
            const unsigned og = xb_add(&bar[XB_TOP], 1u);
            const unsigned tg = og / nx;
            if (og + 1u == (tg + 1u) * nx) xb_add(&bar[XB_TOPGEN], 1u);
            else XB_SPIN(xb_ld(&bar[XB_TOPGEN]) == tg, bar);
            __builtin_amdgcn_fence(__ATOMIC_ACQUIRE, "agent");
            xb_add(&bar[XB_XGEN(b.x)], 1u);
            asm volatile("s_waitcnt vmcnt(0)" ::: "memory");
        } else {
            XB_SPIN(xb_ld(&bar[XB_XGEN(b.x)]) == gen, bar);
            __builtin_amdgcn_fence(__ATOMIC_ACQUIRE, "agent");
            asm volatile("s_waitcnt vmcnt(0)" ::: "memory");
        }
    }
    __syncthreads();
}

struct Params { const float* in[34]; float* out; unsigned char* ws; int two; int pad; };

__device__ __forceinline__ unsigned cvt_pk_bf16(float lo, float hi) { unsigned r; asm("v_cvt_pk_bf16_f32 %0, %1, %2" : "=v"(r) : "v"(lo), "v"(hi)); return r; }
__device__ __forceinline__ u32x4 pack8(f32x4 a, f32x4 b) { u32x4 w; w.x = cvt_pk_bf16(a[0], a[1]); w.y = cvt_pk_bf16(a[2], a[3]); w.z = cvt_pk_bf16(b[0], b[1]); w.w = cvt_pk_bf16(b[2], b[3]); return w; }
__device__ __forceinline__ void unpack8(u32x4 w, f32x4& a, f32x4& b) {
    a[0] = __uint_as_float(w.x << 16); a[1] = __uint_as_float(w.x & 0xffff0000u); a[2] = __uint_as_float(w.y << 16); a[3] = __uint_as_float(w.y & 0xffff0000u);
    b[0] = __uint_as_float(w.z << 16); b[1] = __uint_as_float(w.z & 0xffff0000u); b[2] = __uint_as_float(w.w << 16); b[3] = __uint_as_float(w.w & 0xffff0000u);
}
__device__ __forceinline__ float fast_sigmoid(float x) { return __builtin_amdgcn_rcpf(1.0f + __expf(-x)); }
__device__ __forceinline__ float sum4(f32x4 v) { return (v[0] + v[1]) + (v[2] + v[3]); }
__device__ __forceinline__ float sumsq4(f32x4 v) { return (v[0] * v[0] + v[1] * v[1]) + (v[2] * v[2] + v[3] * v[3]); }
__device__ __forceinline__ float max4(f32x4 v) { return fmaxf(fmaxf(v[0], v[1]), fmaxf(v[2], v[3])); }

__device__ __forceinline__ int lds_byte(int r, int c) { const int st = (r >> 4) * 2 + (c >> 5), rr = r & 15, cc = c & 31, ob = rr * 64 + cc * 2; return st * 1024 + (ob ^ (((ob >> 9) & 1) << 5)); }
__device__ __forceinline__ void stage_rc(int b, int& R, int& C) { const int st = b / 1024, sb = b % 1024, swz = sb ^ (((sb >> 9) & 1) << 5); R = (st >> 1) * 16 + swz / 64; C = (st & 1) * 32 + (swz % 64) / 2; }
__device__ __forceinline__ int perm32(int rho) { const int n = rho >> 4, i = rho & 15; return 8 * (i >> 2) + 4 * n + (i & 3); }

struct Unit { const char* A; const char* B; int pm, pn, z, par; };

struct Order {
    const char* A; const char* B; size_t zAhi, zAlo, zBhi, zBlo, tA, tB; int nM, nN, nZ, zsh, remap, G, c;
    const char* A2; const char* B2; size_t tA2, tB2; int nM2, nN2;
    int bsh; size_t bstep;
    __device__ __forceinline__ bool next(int i, Unit& u) const {
        long L = (long)i * G + c; const int per = nM * nN; const long tot = (long)per * nZ;
        if (L < tot) {
            const int z = (int)(L / per); int wgid = (int)(L % per), pm, pn;
            if (remap) {
                const int nwg = per; { const int q = nwg / NXCD, r = nwg % NXCD, xcd = wgid % NXCD, off = wgid / NXCD; wgid = (xcd < r ? xcd * (q + 1) : r * (q + 1) + (xcd - r) * q) + off; }
                const int nig = WGM * nN, gid = wgid / nig, fm = gid * WGM, gsz = (nM - fm) < WGM ? (nM - fm) : WGM;
                pm = fm + ((wgid % nig) % gsz); pn = (wgid % nig) / gsz;
            } else { pm = wgid % nM; pn = wgid / nM; }
            const int zh = z >> zsh, zl = z & ((1 << zsh) - 1);
            u.pm = pm; u.pn = pn; u.z = z; u.A = A + zh * zAhi + zl * zAlo + pm * tA; u.B = B + zh * zBhi + zl * zBlo + pn * tB + (size_t)(pm >> bsh) * bstep; return true;
        }
        L -= tot;
        if (L < (long)nM2 * nN2) { const int pm = (int)(L % nM2), pn = (int)(L / nM2); u.pm = pm; u.pn = pn; u.z = -1; u.A = A2 + pm * tA2; u.B = B2 + pn * tB2; return true; }
        return false;
    }
};

typedef f32x4 (&AccRef)[2][2][4][2];
#define FOR_AM _Pragma("unroll") for (int ai = 0; ai < 2; ++ai) _Pragma("unroll") for (int m = 0; m < 4; ++m)
#define FOR_BJ _Pragma("unroll") for (int bj = 0; bj < 2; ++bj)

template <class Epi>
__device__ __forceinline__ void gemm_phase(const int wid_s, LAS unsigned char* lds, const int lda, const int ldb, const int K, const bool bdup, const Order& S, const Epi& E, const bool agm = false) {
    const int tid = opq_tid(wid_s), wid = wid_s, lane = tid & 63, wr = wid >> 2, wc = wid & 3, fr = lane & 15, fq = lane >> 4;
    const int nt = K / BK;
    unsigned voffA[2], voffB[2];
#pragma unroll
    for (int i = 0; i < 2; ++i) { int R, C; stage_rc(tid * 16 + i * 8192, R, C); const int Rb = (R & ~31) + perm32(R & 31);
        voffA[i] = agm ? (unsigned)((C >> 4) * (T_ * 16) + R * 16 + (C & 15)) * 2u : (unsigned)(R * lda + C) * 2u; voffB[i] = (unsigned)(Rb * ldb + C) * 2u; }
    const size_t kstep = (size_t)(BK * 2), kstepA = agm ? (size_t)4 * T_ * 32 : kstep;
    const size_t hstepA = agm ? (size_t)HALF * 32 : (size_t)HALF * lda * 2, hstepB = bdup ? (size_t)0 : (size_t)HALF * ldb * 2;
    const unsigned ldsw = (unsigned)wid * 1024u;
    const int aoff = lds_byte(wr * 64 + fr, fq * 8), boff = lds_byte(wc * 32 + fr, fq * 8);
#define PG8_SA(b, h) (((b) * 2 + (h)) * HTB)
#define PG8_SB(b, h) ((4 + (b) * 2 + (h)) * HTB)
#define PG8_STAGE(bufoff, gbase, voff) do { _Pragma("unroll") for (int _i = 0; _i < 2; ++_i) \
        __builtin_amdgcn_global_load_lds((const unsigned*)((const char*)(gbase) + (voff)[_i]), (LAS unsigned*)(lds + (bufoff) + ldsw + _i * 8192), 16, 0, 0); } while (0)
#define PG8_LDA(dst, b, h) do { _Pragma("unroll") for (int m = 0; m < 4; ++m) _Pragma("unroll") for (int k = 0; k < 2; ++k) dst[m][k] = *(const LAS bf16x8*)(lds + PG8_SA(b, h) + aoff + m * 2048 + k * 1024); } while (0)
#define PG8_LDB(dst, b, h) do { _Pragma("unroll") for (int n = 0; n < 2; ++n) _Pragma("unroll") for (int k = 0; k < 2; ++k) dst[n][k] = *(const LAS bf16x8*)(lds + PG8_SB(b, h) + boff + n * 2048 + k * 1024); } while (0)
#define PG8_MMA(ai, bj, At, Bt) do { __builtin_amdgcn_s_setprio(1); _Pragma("unroll") for (int m = 0; m < 4; ++m) _Pragma("unroll") for (int n = 0; n < 2; ++n) _Pragma("unroll") for (int k = 0; k < 2; ++k) \
        acc[ai][bj][m][n] = __builtin_amdgcn_mfma_f32_16x16x32_bf16(Bt[n][k], At[m][k], acc[ai][bj][m][n], 0, 0, 0); __builtin_amdgcn_s_setprio(0); } while (0)
#define PG8_WAIT_V(n) asm volatile("s_waitcnt vmcnt(" #n ")" ::: "memory")
#define PG8_WAIT_L(n) asm volatile("s_waitcnt lgkmcnt(" #n ")" ::: "memory")
#define PG8_BAR __builtin_amdgcn_s_barrier()
#define PG8_SCHED __builtin_amdgcn_sched_barrier(0)
    Unit cur, nxt; int ui = 0;
    if (!S.next(0, cur)) return;
    f32x4 acc[2][2][4][2];
#pragma unroll
    for (int a = 0; a < 2; ++a)
#pragma unroll
        for (int b = 0; b < 2; ++b)
#pragma unroll
            for (int m = 0; m < 4; ++m)
#pragma unroll
                for (int n = 0; n < 2; ++n) acc[a][b][m][n] = (f32x4){0.f, 0.f, 0.f, 0.f};
    bf16x8 At[4][2], B0[2][2], B1[2][2];
    const char* cA = cur.A; const char* cB = cur.B; cur.par = 0;
    if constexpr (Epi::PRE) E.prefetch(cur, tid);
    PG8_STAGE(PG8_SB(0, 0), cB, voffB); PG8_STAGE(PG8_SA(0, 0), cA, voffA); PG8_STAGE(PG8_SB(0, 1), cB + hstepB, voffB); PG8_STAGE(PG8_SA(0, 1), cA + hstepA, voffA);
    if (wr == 1) PG8_BAR;
    PG8_WAIT_V(4); PG8_BAR;
    PG8_STAGE(PG8_SB(1, 0), cB + kstep, voffB); PG8_STAGE(PG8_SA(1, 0), cA + kstepA, voffA); PG8_STAGE(PG8_SB(1, 1), cB + hstepB + kstep, voffB);
    PG8_WAIT_V(6); PG8_BAR;
    for (;;) {
        const bool has_next = S.next(ui + 1, nxt); nxt.par = (ui + 1) & 1;
        const char* nA = has_next ? nxt.A : cA; const char* nB = has_next ? nxt.B : cB;
#pragma unroll 1
        for (int t = 0; t < nt; t += 2) {
            const bool last = (t == nt - 2);
            const char* a1 = cA + (size_t)(t + 1) * kstepA;
            const char* a2 = last ? nA : cA + (size_t)(t + 2) * kstepA; const char* b2 = last ? nB : cB + (size_t)(t + 2) * kstep;
            const char* a3 = a2 + kstepA; const char* b3 = b2 + kstep;
            PG8_LDB(B0, 0, 0); PG8_SCHED; PG8_LDA(At, 0, 0); PG8_STAGE(PG8_SA(1, 1), a1 + hstepA, voffA);
            PG8_WAIT_L(8); PG8_BAR; PG8_WAIT_L(0); PG8_MMA(0, 0, At, B0); PG8_BAR; PG8_SCHED;
            PG8_LDB(B1, 0, 1); PG8_STAGE(PG8_SB(0, 0), b2, voffB);
            PG8_BAR; PG8_WAIT_L(0); PG8_MMA(0, 1, At, B1); PG8_BAR;
            PG8_LDA(At, 0, 1); PG8_STAGE(PG8_SA(0, 0), a2, voffA);
            PG8_BAR; PG8_WAIT_L(0); PG8_MMA(1, 0, At, B0); PG8_BAR; PG8_SCHED;
            PG8_STAGE(PG8_SB(0, 1), b2 + hstepB, voffB);
            PG8_WAIT_V(6); PG8_BAR; PG8_MMA(1, 1, At, B1); PG8_BAR;
            PG8_LDB(B0, 1, 0); PG8_SCHED; PG8_LDA(At, 1, 0); PG8_STAGE(PG8_SA(0, 1), a2 + hstepA, voffA);
            PG8_WAIT_L(8); PG8_BAR; PG8_WAIT_L(0); PG8_MMA(0, 0, At, B0); PG8_BAR; PG8_SCHED;
            PG8_LDB(B1, 1, 1); PG8_STAGE(PG8_SB(1, 0), b3, voffB);
            PG8_BAR; PG8_WAIT_L(0); PG8_MMA(0, 1, At, B1); PG8_BAR;
            PG8_LDA(At, 1, 1); PG8_STAGE(PG8_SA(1, 0), a3, voffA);
            PG8_BAR; PG8_WAIT_L(0); PG8_MMA(1, 0, At, B0); PG8_BAR; PG8_SCHED;
            PG8_STAGE(PG8_SB(1, 1), b3 + hstepB, voffB);
            PG8_WAIT_V(6); PG8_BAR; PG8_MMA(1, 1, At, B1); PG8_BAR;
        }
        { int fr_e = fr, fq_e = fq; asm volatile("" : "+v"(fr_e), "+v"(fq_e));
          E(acc, cur, wr, wc, fr_e, fq_e);
          if constexpr (Epi::PRE) { if (has_next) { int t_e = tid; asm volatile("" : "+v"(t_e)); E.prefetch(nxt, t_e); } } }
        if (!has_next) break;
#pragma unroll
        for (int a = 0; a < 2; ++a)
#pragma unroll
            for (int b = 0; b < 2; ++b)
#pragma unroll
                for (int m = 0; m < 4; ++m)
#pragma unroll
                    for (int n = 0; n < 2; ++n) acc[a][b][m][n] = (f32x4){0.f, 0.f, 0.f, 0.f};
        cur = nxt; cA = nA; cB = nB; ++ui;
    }
    PG8_WAIT_V(0);
    if (wr == 0) PG8_BAR;
    PG8_BAR;
#undef PG8_SA
#undef PG8_SB
#undef PG8_STAGE
#undef PG8_LDA
#undef PG8_LDB
#undef PG8_MMA
#undef PG8_WAIT_V
#undef PG8_WAIT_L
#undef PG8_BAR
#undef PG8_SCHED
}

#define ATOMIC_ROWS(ssq_out_, row0_, fq_, ssv_) do { \
    const float v0_ = ((fq_) == 0) ? ssv_[0][0] : ((fq_) == 1) ? ssv_[0][1] : ((fq_) == 2) ? ssv_[0][2] : ssv_[0][3]; \
    const float v1_ = ((fq_) == 0) ? ssv_[1][0] : ((fq_) == 1) ? ssv_[1][1] : ((fq_) == 2) ? ssv_[1][2] : ssv_[1][3]; \
    unsafeAtomicAdd((ssq_out_) + (row0_) + (fq_) * 16, v0_); unsafeAtomicAdd((ssq_out_) + (row0_) + HALF + (fq_) * 16, v1_); } while (0)


typedef float f32x2 __attribute__((ext_vector_type(2)));
struct EpiGateUp {
    static constexpr bool MID = false, PRE = true;
    const float* ssq; bf16_t* act; LAS float* tab;
    __device__ __forceinline__ void prefetch(const Unit& u, int tid) const {
        if (tid < 256) tab[u.par * 256 + tid] = rsqrtf(ssq[u.pm * BM + tid] * (1.0f / D_) + EPS_);
    }
    __device__ __forceinline__ void operator()(AccRef acc, const Unit& u, int wr, int wc, int fr, int fq) const {
        const int colt = wc * 32 + fq * 8, row0 = u.pm * BM + wr * 64 + fr;
        const LAS float* tp = tab + u.par * 256 + wr * 64 + fr;
        for (int rep_ = 0; rep_ < (PROBE == 8 ? 2 : 1); ++rep_)
        FOR_AM { const int row = row0 + ai * HALF + m * 16; const float rs = tp[ai * HALF + m * 16]; const float c = -1.4426950408889634f * rs, rs2 = rs * rs;
            u32x4 w;
#pragma unroll
            for (int n = 0; n < 2; ++n)
#pragma unroll
                for (int h = 0; h < 2; ++h) { const f32x2 g = {acc[ai][0][m][n][2 * h], acc[ai][0][m][n][2 * h + 1]}, uu = {acc[ai][1][m][n][2 * h], acc[ai][1][m][n][2 * h + 1]};
                    const f32x2 t = g * c; f32x2 e; e.x = __builtin_amdgcn_exp2f(t.x); e.y = __builtin_amdgcn_exp2f(t.y);
                    const f32x2 d = e + 1.0f; f32x2 r; r.x = __builtin_amdgcn_rcpf(d.x); r.y = __builtin_amdgcn_rcpf(d.y);
                    const f32x2 o = (g * uu) * (r * rs2);
                    w[n * 2 + h] = cvt_pk_bf16(o.x, o.y); }
            *(u32x4*)(act + (size_t)row * FF_ + u.pn * HALF + colt) = w; }
    }
};

struct EpiKV {
    static constexpr bool MID = false, PRE = false;
    const float* ssq_m; bf16_t* kmat; bf16_t* vmat;
    __device__ __forceinline__ void operator()(AccRef acc, const Unit& u, int wr, int wc, int fr, int fq) const {
        const int colt = wc * 32 + fq * 8, row0 = u.pm * BM + wr * 64 + fr;
        bf16_t* dst = (u.pn < 8) ? kmat : vmat; const int pnl = u.pn & 7;
        float rsv[2][4];
        FOR_AM rsv[ai][m] = ssq_m[row0 + ai * HALF + m * 16];
        FOR_AM { const int row = row0 + ai * HALF + m * 16; const float rs = rsqrtf(rsv[ai][m] * (1.0f / D_) + EPS_);
            FOR_BJ *(u32x4*)(dst + (size_t)row * D_ + pnl * BM + bj * HALF + colt) = pack8(acc[ai][bj][m][0] * rs, acc[ai][bj][m][1] * rs); }
    }
};

struct EpiStore {
    static constexpr bool MID = false, PRE = false;
    bf16_t* out; int ld; float scale; int mode;
    __device__ __forceinline__ void operator()(AccRef acc, const Unit& u, int wr, int wc, int fr, int fq) const {
        const int colt = wc * 32 + fq * 8, rl0 = wr * 64 + fr;
        const int rowbase = mode ? ((u.z >> 2) * 2048 + u.pm * BM) : (u.z * 256), colbase = mode ? ((u.z & 3) * 256) : (u.pn * BM);
        FOR_AM { const int row = rowbase + rl0 + ai * HALF + m * 16;
            FOR_BJ *(u32x4*)(out + (size_t)row * ld + colbase + bj * HALF + colt) = pack8(acc[ai][bj][m][0] * scale, acc[ai][bj][m][1] * scale); }
    }
};

struct EpiResid {
    static constexpr bool MID = false, PRE = false;
    bf16_t* hb; float* ssq_out; float alpha;
    __device__ __forceinline__ void operator()(AccRef acc, const Unit& u, int wr, int wc, int fr, int fq) const {
        const int L_ = lane_fresh(), i16 = (L_ ^ 16) << 2, i32 = (L_ ^ 32) << 2;
        const int colt = wc * 32 + fq * 8, row0 = u.pm * BM + wr * 64 + fr;
        bf16_t* base = hb + (size_t)row0 * D_ + u.pn * BM + colt;
        u32x4 rr[2][4][2];
        FOR_AM { FOR_BJ rr[ai][m][bj] = *(const u32x4*)(base + (size_t)(ai * HALF + m * 16) * D_ + bj * HALF); }
        float ssv[2][4];
        FOR_AM { float ss = 0.f;
            FOR_BJ { f32x4 r0, r1; unpack8(rr[ai][m][bj], r0, r1);
                const f32x4 h0 = r0 + acc[ai][bj][m][0] * alpha, h1 = r1 + acc[ai][bj][m][1] * alpha;
                *(u32x4*)(base + (size_t)(ai * HALF + m * 16) * D_ + bj * HALF) = pack8(h0, h1); ss += sumsq4(h0) + sumsq4(h1); }
            ss += xshfl(ss, i16); ss += xshfl(ss, i32); ssv[ai][m] = ss; }
        ATOMIC_ROWS(ssq_out, row0, fq, ssv);
    }
};

struct EpiResid2 {
    static constexpr bool MID = false, PRE = false;
    bf16_t* hb; float* ssq_out; const float* ssq_s; const float* ssq_p; int zbase;
    __device__ __forceinline__ void operator()(AccRef acc, const Unit& u, int wr, int wc, int fr, int fq) const {
        const int L_ = lane_fresh(), i16 = (L_ ^ 16) << 2, i32 = (L_ ^ 32) << 2;
        const int colt = wc * 32 + fq * 8, row0 = u.pm * BM + wr * 64 + fr, half = u.z + zbase;
        const float* sq = half ? ssq_p : ssq_s;
        bf16_t* base = hb + (size_t)row0 * D_ + u.pn * BM + colt;
        float rsv[2][4]; u32x4 rr[2][4][2];
        FOR_AM rsv[ai][m] = sq[row0 + ai * HALF + m * 16];
        FOR_AM { FOR_BJ rr[ai][m][bj] = *(const u32x4*)(base + (size_t)(ai * HALF + m * 16) * D_ + bj * HALF); }
        float ssv[2][4];
        FOR_AM { const float rs = rsqrtf(rsv[ai][m] * (1.0f / 1024) + EPS_); float ss = 0.f;
            FOR_BJ { f32x4 r0, r1; unpack8(rr[ai][m][bj], r0, r1);
                const f32x4 h0 = r0 + acc[ai][bj][m][0] * rs, h1 = r1 + acc[ai][bj][m][1] * rs;
                *(u32x4*)(base + (size_t)(ai * HALF + m * 16) * D_ + bj * HALF) = pack8(h0, h1); ss += sumsq4(h0) + sumsq4(h1); }
            ss += xshfl(ss, i16); ss += xshfl(ss, i32); ssv[ai][m] = ss; }
        if (half == 1) ATOMIC_ROWS(ssq_out, row0, fq, ssv);
    }
};

struct EpiWin {
    static constexpr bool MID = false, PRE = true;
    const float* ssq; bf16_t* apr; bf16_t* mrg; LAS float* tab;
    __device__ __forceinline__ void prefetch(const Unit& u, int tid) const {
        if (tid < 256) tab[u.par * 256 + tid] = rsqrtf(ssq[u.pm * BM + tid] * (1.0f / D_) + EPS_);
    }
    __device__ __forceinline__ void operator()(AccRef acc, const Unit& u, int wr, int wc, int fr, int fq) const {
        const int colt = wc * 32 + fq * 8, row0 = u.pm * BM + wr * 64 + fr;
        const LAS float* tp = tab + u.par * 256 + wr * 64 + fr;
        FOR_AM { const int row = row0 + ai * HALF + m * 16; const float rs = tp[ai * HALF + m * 16];
            FOR_BJ { const int gc = u.pn * BM + bj * HALF + colt; const u32x4 w = pack8(acc[ai][bj][m][0] * rs, acc[ai][bj][m][1] * rs);
                if (gc < 1024) { const int g = gc >> 4, h0 = gc & 15, n = row >> 4, tau = row & 15;
                    *(u32x4*)(apr + ((size_t)(g * 1024 + n)) * 384 + tau * 16 + h0) = w; }
                else *(u32x4*)(mrg + (size_t)row * D_ + gc) = w; } }
    }
};

struct EpiSloc {
    static constexpr bool MID = false, PRE = false;
    float* sloc;
    __device__ __forceinline__ void operator()(AccRef acc, const Unit& u, int wr, int wc, int fr, int fq) const {
        const int colt = wc * 32 + fq * 8, row0 = u.pm * BM + wr * 64 + fr;
        FOR_AM { const int n = row0 + ai * HALF + m * 16; float* p = sloc + ((size_t)(u.z * 1024 + n)) * 128 + colt;
            *(f32x4*)p = acc[ai][0][m][0]; *(f32x4*)(p + 4) = acc[ai][0][m][1]; }
    }
};

struct EpiY {
    static constexpr bool MID = false, PRE = false;
    const bf16_t* apr; const float* dskip; bf16_t* ys;
    __device__ __forceinline__ void operator()(AccRef acc, const Unit& u, int wr, int wc, int fr, int fq) const {
        const int colt = wc * 32 + fq * 8, row0 = u.pm * BM + wr * 64 + fr, g = u.z, ho = colt & 15;
        const f32x4 d0 = *(const f32x4*)(dskip + g * 16 + ho), d1 = *(const f32x4*)(dskip + g * 16 + ho + 4);
        u32x4 uu[2][4][2];
        FOR_AM { FOR_BJ uu[ai][m][bj] = *(const u32x4*)(apr + ((size_t)(g * 1024 + row0 + ai * HALF + m * 16)) * 384 + bj * HALF + colt); }
        FOR_AM { const int n = row0 + ai * HALF + m * 16;
            FOR_BJ { const int col = bj * HALF + colt;
                f32x4 u0, u1; unpack8(uu[ai][m][bj], u0, u1);
                f32x4 y0 = acc[ai][bj][m][0] + d0 * u0, y1 = acc[ai][bj][m][1] + d1 * u1;
#pragma unroll
                for (int j = 0; j < 4; ++j) { const float a = y0[j], b = y1[j];
                    y0[j] = a * fast_sigmoid(1.5957691216f * (a + 0.044715f * a * a * a)); y1[j] = b * fast_sigmoid(1.5957691216f * (b + 0.044715f * b * b * b)); }
                *(u32x4*)(ys + ((size_t)g * T_ + (size_t)n * 16) * 16 + col) = pack8(y0, y1); } }
    }
};

struct EpiGlu {
    static constexpr bool MID = false, PRE = false;
    const bf16_t* ys; const float* bglu; bf16_t* mrg; float* ssq_out;
    __device__ __forceinline__ void operator()(AccRef acc, const Unit& u, int wr, int wc, int fr, int fq) const {
        const int L_ = lane_fresh(), i16 = (L_ ^ 16) << 2, i32 = (L_ ^ 32) << 2;
        const int colt = wc * 32 + fq * 8, row0 = u.pm * BM + wr * 64 + fr;
        f32x4 bb[2][2];
        FOR_BJ { const int gc = u.pn * BM + bj * HALF + colt; bb[bj][0] = *(const f32x4*)(bglu + gc); bb[bj][1] = *(const f32x4*)(bglu + gc + 4); }
        u32x4 yy[2][4][2];
        FOR_AM { FOR_BJ { const int gc = u.pn * BM + bj * HALF + colt; yy[ai][m][bj] = *(const u32x4*)(ys + ((size_t)(gc >> 4) * T_ + row0 + ai * HALF + m * 16) * 16 + (gc & 15)); } }
        float ssv[2][4];
        FOR_AM { const int row = row0 + ai * HALF + m * 16; float ss = 0.f;
            FOR_BJ { const int gc = u.pn * BM + bj * HALF + colt;
                f32x4 y0, y1; unpack8(yy[ai][m][bj], y0, y1);
                f32x4 o0, o1;
#pragma unroll
                for (int j = 0; j < 4; ++j) { o0[j] = y0[j] * fast_sigmoid(acc[ai][bj][m][0][j] + bb[bj][0][j]); o1[j] = y1[j] * fast_sigmoid(acc[ai][bj][m][1][j] + bb[bj][1][j]); }
                *(u32x4*)(mrg + (size_t)row * D_ + gc) = pack8(o0, o1); ss += sumsq4(o0) + sumsq4(o1); }
            ss += xshfl(ss, i16); ss += xshfl(ss, i32); ssv[ai][m] = ss; }
        ATOMIC_ROWS(ssq_out, row0, fq, ssv);
    }
};

struct EpiPool {
    static constexpr bool MID = false, PRE = false;
    const float* pscale; bf16_t* mrg; float* ssq_out;
    __device__ __forceinline__ void operator()(AccRef acc, const Unit& u, int wr, int wc, int fr, int fq) const {
        const int L_ = lane_fresh(), i16 = (L_ ^ 16) << 2, i32 = (L_ ^ 32) << 2;
        const int colt = wc * 32 + fq * 8, row0 = u.pm * BM + wr * 64 + fr;
        f32x4 sc[2][2];
        FOR_BJ { const int pc = u.z * 256 + bj * HALF + colt; sc[bj][0] = *(const f32x4*)(pscale + pc); sc[bj][1] = *(const f32x4*)(pscale + pc + 4); }
        float ssv[2][4];
        FOR_AM { const int row = row0 + ai * HALF + m * 16; float ss = 0.f;
            FOR_BJ { const int pc = u.z * 256 + bj * HALF + colt;
                const f32x4 o0 = acc[ai][bj][m][0] * sc[bj][0], o1 = acc[ai][bj][m][1] * sc[bj][1];
                *(u32x4*)(mrg + (size_t)row * D_ + 1024 + pc) = pack8(o0, o1); ss += sumsq4(o0) + sumsq4(o1); }
            ss += xshfl(ss, i16); ss += xshfl(ss, i32); ssv[ai][m] = ss; }
        ATOMIC_ROWS(ssq_out, row0, fq, ssv);
    }
};

struct EpiSoftmax {
    static constexpr bool MID = false, PRE = false;
    const float* ssq; bf16_t* pm_; LAS float* red;
    __device__ __forceinline__ void operator()(AccRef acc, const Unit& u, int wr, int wc, int fr, int fq) const {
        const int L_ = lane_fresh(), i16 = (L_ ^ 16) << 2, i32 = (L_ ^ 32) << 2;
        const int colt = wc * 32 + fq * 8, rl0 = wr * 64 + fr, grow0 = (u.z >> 2) * 4096 + u.pm * BM, hd = u.z & 3;
        FOR_AM { const float rs = rsqrtf(ssq[grow0 + rl0 + ai * HALF + m * 16] * (1.0f / D_) + EPS_); float v = -3.0e38f;
            FOR_BJ { acc[ai][bj][m][0] *= rs; acc[ai][bj][m][1] *= rs; v = fmaxf(v, fmaxf(max4(acc[ai][bj][m][0]), max4(acc[ai][bj][m][1]))); }
            v = fmaxf(v, xshfl(v, i16)); v = fmaxf(v, xshfl(v, i32));
            if (fq == 0) red[(rl0 + ai * HALF + m * 16) * 4 + wc] = v; }
        __syncthreads();
        FOR_AM { const f32x4 r4 = *(const LAS f32x4*)(red + (rl0 + ai * HALF + m * 16) * 4); const float mx = max4(r4); float s = 0.f;
            FOR_BJ {
#pragma unroll
                for (int n = 0; n < 2; ++n)
#pragma unroll
                    for (int j = 0; j < 4; ++j) { const float e = __expf(acc[ai][bj][m][n][j] - mx); acc[ai][bj][m][n][j] = e; s += e; } }
            s += xshfl(s, i16); s += xshfl(s, i32);
            if (fq == 0) red[1024 + (rl0 + ai * HALF + m * 16) * 4 + wc] = s; }
        __syncthreads();
        FOR_AM { const int rl = rl0 + ai * HALF + m * 16; const f32x4 r4 = *(const LAS f32x4*)(red + 1024 + rl * 4); const float inv = 1.0f / sum4(r4);
            FOR_BJ *(u32x4*)(pm_ + ((size_t)(grow0 + rl)) * 1024 + hd * 256 + bj * HALF + colt) = pack8(acc[ai][bj][m][0] * inv, acc[ai][bj][m][1] * inv); }
    }
};

struct EpiNull {
    static constexpr bool MID = false, PRE = false;
    float* sink;
    __device__ __forceinline__ void operator()(AccRef acc, const Unit& u, int wr, int wc, int fr, int fq) const {
        f32x4 s = {0.f, 0.f, 0.f, 0.f};
        FOR_AM { FOR_BJ { s += acc[ai][bj][m][0]; s += acc[ai][bj][m][1]; } }
        if (sum4(s) == 12345.678f) sink[fr] = 1.0f;
    }
};

__device__ __forceinline__ void tconv_tile(const int tid, LAS unsigned char* lds, const float* W, int N, int k0, int n0, const float* gA, const float* gB, int ksplit, bf16_t* out, int ldb, int mode, int rowbase) {
    LAS unsigned* tile = (LAS unsigned*)lds;
    f32x4 v[8];
#pragma unroll
    for (int it = 0; it < 8; ++it) v[it] = *(const f32x4*)(W + (size_t)(k0 + it * 8 + (tid >> 6)) * N + n0 + (tid & 63) * 4);
#pragma unroll
    for (int it = 0; it < 8; ++it) { const int k = it * 8 + (tid >> 6), kk = k0 + k; float g = 1.0f; if (gA) g = (kk < ksplit) ? gA[kk] : gB[kk - ksplit];
        tile[k * 129 + (tid & 63) * 2] = cvt_pk_bf16(v[it][0] * g, v[it][1] * g); tile[k * 129 + (tid & 63) * 2 + 1] = cvt_pk_bf16(v[it][2] * g, v[it][3] * g); }
    __syncthreads();
    const LAS bf16_t* t16 = (const LAS bf16_t*)lds;
#pragma unroll
    for (int it = 0; it < 4; ++it) { const int c = it * 512 + tid, n = c >> 3, kc = c & 7; unsigned e[8];
#pragma unroll
        for (int i = 0; i < 8; ++i) e[i] = t16[(kc * 8 + i) * 258 + n];
        u32x4 w; w.x = e[0] | (e[1] << 16); w.y = e[2] | (e[3] << 16); w.z = e[4] | (e[5] << 16); w.w = e[6] | (e[7] << 16);
        const int nn = n0 + n; const int ro = mode ? ((nn >> 7) * 256 + (nn & 127) + rowbase) : (nn + rowbase);
        *(u32x4*)(out + (size_t)ro * ldb + k0 + kc * 8) = w; }
    __syncthreads();
}

__device__ __forceinline__ void rows_to_bf16_ssq(const int tid, const float* src, bf16_t* dst, float* ssq, int nrows) {
    const int lane = tid & 63, gw = blockIdx.x * 8 + (tid >> 6), nw = gridDim.x * 8;
    for (int row = gw; row < nrows; row += nw) { const f32x4* p = (const f32x4*)(src + (size_t)row * D_); u32x2* q = (u32x2*)(dst + (size_t)row * D_); float ss = 0.f;
        f32x4 v[8];
#pragma unroll
        for (int i = 0; i < 8; ++i) v[i] = p[lane + 64 * i];
#pragma unroll
        for (int i = 0; i < 8; ++i) { ss += sumsq4(v[i]); u32x2 w; w.x = cvt_pk_bf16(v[i][0], v[i][1]); w.y = cvt_pk_bf16(v[i][2], v[i][3]); q[lane + 64 * i] = w; }
#pragma unroll
        for (int o = 32; o > 0; o >>= 1) ss += xshfl(ss, (lane ^ o) << 2);
        if (lane == 0) ssq[row] = ss; }
}


template <int W> __device__ __forceinline__ void pooled_w(const bf16_t* mrg, bf16_t* apool, const int gi, const int gt, const int nth) {
    for (int it = gt; it < T_ * 32; it += nth) { const int c = it & 31, t = it >> 5, ch = gi * 256 + c * 8, l = t & 4095;
        const bf16_t* src = mrg + (size_t)t * D_ + 1024 + ch; u32x4 r[W];
#pragma unroll
        for (int d = 0; d < W; ++d) { r[d] = (u32x4){0u, 0u, 0u, 0u}; if (d <= l) r[d] = *(const u32x4*)(src - (size_t)d * D_); }
        f32x4 c0, c1; unpack8(r[0], c0, c1); f32x4 s0 = c0, s1 = c1;
#pragma unroll
        for (int d = 1; d < W; ++d) { f32x4 a0, a1; unpack8(r[d], a0, a1); s0 += a0; s1 += a1; }
        const int cnt = (l + 1 < W) ? (l + 1) : W; const float ic = 1.0f / (float)cnt;
        *(u32x4*)(apool + (size_t)t * 1024 + ch) = pack8(s0 * ic - c0, s1 * ic - c1); }
}

#define W1GU ((bf16_t*)(P.ws + WS_W1GU))
#define W1D ((bf16_t*)(P.ws + WS_W1D))
#define W2GU ((bf16_t*)(P.ws + WS_W2GU))
#define W2D ((bf16_t*)(P.ws + WS_W2D))
#define WIN ((bf16_t*)(P.ws + WS_WIN))
#define WOUT ((bf16_t*)(P.ws + WS_WOUT))
#define WQ ((bf16_t*)(P.ws + WS_WQ))
#define WO ((bf16_t*)(P.ws + WS_WO))
#define WKV ((bf16_t*)(P.ws + WS_WKV))
#define WGLU ((bf16_t*)(P.ws + WS_WGLU))
#define WP ((bf16_t*)(P.ws + WS_WP))
#define PMAT ((bf16_t*)(P.ws + WS_PMAT))
#define TQ ((bf16_t*)(P.ws + WS_TQ))
#define APOW ((float2*)(P.ws + WS_APOW))
#define BBAR ((float2*)(P.ws + WS_BBAR))
#define KM ((float*)(P.ws + WS_KM))
#define MEMB ((bf16_t*)(P.ws + WS_MEMB))
#define KMAT ((bf16_t*)(P.ws + WS_KMAT))
#define VT ((bf16_t*)(P.ws + WS_VT))
#define HB ((bf16_t*)(P.ws + WS_HB))
#define SSQ ((float*)(P.ws + WS_SSQ))
#define ACT ((bf16_t*)((P.ws + WS_X) + X_ACT))
#define APR ((bf16_t*)((P.ws + WS_X) + X_APR))
#define MRG ((bf16_t*)((P.ws + WS_X) + X_MRG))
#define APOOL ((bf16_t*)((P.ws + WS_X) + X_APOOL))
#define YS ((bf16_t*)((P.ws + WS_X) + X_YS))
#define SLOC ((float*)((P.ws + WS_X) + X_SLOC))
#define MT ((bf16_t*)(P.ws + WS_MT))
#define VWT ((bf16_t*)(P.ws + WS_VWT))
#define PMb ((bf16_t*)((P.ws + WS_X) + X_P))
#define ssq_x (SSQ + 0 * T_)
#define ssq_mem (SSQ + 1 * T_)
#define ssq1 (SSQ + 2 * T_)
#define ssq_ssm (SSQ + 3 * T_)
#define ssq_pool (SSQ + 4 * T_)
#define ssq2 (SSQ + 5 * T_)
#define ssq3 (SSQ + 6 * T_)
#define ssq4 (SSQ + 7 * T_)
#define HF (P.out)

__device__ __forceinline__ void tconv_job(const Params& P, const int tid, LAS unsigned char* lds, const int tI) {
    int id = tI; const float* W; int K, N, ldb, mode = 0, rowbase = 0, ksplit; const float* gA = nullptr; const float* gB = nullptr; bf16_t* out;
    if (id < 4224) { const int j = id / 704; id -= j * 704; const int l = j / 3, r = j % 3;
        if (r < 2) { W = P.in[l ? (30 + r) : (3 + r)]; K = D_; N = FF_; out = l ? W2GU : W1GU; ldb = D_; mode = 1; rowbase = r * 128; gA = P.in[l ? 29 : 2]; }
        else { W = P.in[l ? 32 : 5]; K = FF_; N = D_; out = l ? W2D : W1D; ldb = FF_; } }
    else if (id < 4224 + 1536) { id -= 4224; const int j = id >> 8; id &= 255; K = D_; N = D_; ldb = D_;
        if (j == 0) { W = P.in[7]; out = WIN; gA = P.in[6]; }
        else if (j == 1) { W = P.in[22]; out = WOUT; gA = P.in[20]; gB = P.in[21]; }
        else if (j == 2) { return; }
        else if (j == 3) { W = P.in[26]; out = WKV; gA = P.in[24]; }
        else if (j == 4) { W = P.in[27]; out = WKV + (size_t)D_ * D_; gA = P.in[24]; }
        else { W = P.in[28]; out = WO; } }
    else if (id < 4224 + 1536 + 64) { id -= 4224 + 1536; W = P.in[16]; K = 1024; N = 1024; ldb = 1024; out = WGLU; }
    else { id -= 4224 + 1536 + 64; const int gi = id >> 2; id &= 3; W = P.in[18] + (size_t)gi * 65536; K = 256; N = 256; ldb = 256; out = WP + (size_t)gi * 65536; }
    ksplit = gB ? 1024 : K;
    const int nkt = K / 64; const int kt = id % nkt, ntile = id / nkt;
    tconv_tile(tid, lds, W, N, kt * 64, ntile * 256, gA, gB, ksplit, out, ldb, mode, rowbase);
}

__global__ void __launch_bounds__(512, 2) mega(Params P) {
    extern __shared__ __attribute__((aligned(16))) unsigned char lds_raw[];
    LAS unsigned char* lds = (LAS unsigned char*)lds_raw;
    cg::grid_group grid = cg::this_grid();
    const int G = gridDim.x, bx = blockIdx.x, nth = G * 512;
    const int wid_s = __builtin_amdgcn_readfirstlane(threadIdx.x >> 6);
#define PHASE_TID const int tid = opq_tid(wid_s); const int gt = bx * 512 + tid; (void)gt
    const float* x = P.in[0];

    Order S{}; S.G = G; S.c = bx;
    unsigned* BAR = (unsigned*)(P.ws + WS_BAR);
    volatile LAS unsigned* bst = (volatile LAS unsigned*)(lds + STAGE_BYTES + 8192);
    { const int t0 = opq_tid(wid_s); if (t0 < 2) bst[t0] = 0u;
      if (bx == 0) { for (int i = t0; i < XCD_BAR_WORDS; i += 512) BAR[i] = 0u; } }

#pragma unroll 1
    for (int pass = 0; pass < P.two; ++pass) {
        PHASE_TID;
        const int nkv = (G >= 128) ? 64 : 0;
        int start, stride, hi;
        const int nt_kv = 0;
        if (pass == 0) { start = 4224 + bx; stride = G; hi = 5840; } else if (bx >= nkv) { start = bx - nkv; stride = G - nkv; hi = 4224 - nt_kv; } else { start = 4224 - nt_kv + bx; stride = nkv; hi = 4224; }
        for (int tI = start; tI < hi; tI += stride) tconv_job(P, tid, lds, tI);
        if (pass == 0) {
            rows_to_bf16_ssq(tid, x, HB, ssq_x, T_);
            rows_to_bf16_ssq(tid, P.in[1], MEMB, ssq_mem, 1024);
            for (int i = gt; i < 6 * T_; i += nth) ssq1[i] = 0.f;
            for (int i = gt; i < D_ * D_ / 8; i += nth) { const int c = i >> 8; const float g = P.in[23][c]; const f32x4 a = *(const f32x4*)(P.in[25] + (size_t)i * 8), b = *(const f32x4*)(P.in[25] + (size_t)i * 8 + 4);
                *(u32x4*)(WQ + (size_t)i * 8) = pack8(a * g, b * g); }
            for (int item = gt; item < 4096 * 17; item += nth) {
                const int idx = item / 17, k = item - idx * 17, g = idx >> 6; const double dt = exp((double)P.in[10][g]); const float lr = P.in[8][idx], li = P.in[9][idx];
                const double xk = (double)lr * dt * k; double rev = (double)li * dt * k * 0.15915494309189535; rev -= rint(rev);
                const float a = (float)(rev * 6.283185307179586), xf = (float)xk; const float mag = expf(xf), cs = cosf(a), sn = sinf(a);
                APOW[item] = make_float2(mag * cs, mag * sn);
                if (k == 1) { const float a1i = mag * sn; const float sh = sinf(0.5f * a); const float nr1 = expm1f(xf) * cs - 2.0f * sh * sh;
                    const float den = lr * lr + li * li, fr_ = (nr1 * lr + a1i * li) / den, fi_ = (a1i * lr - nr1 * li) / den;
#pragma unroll 4
                    for (int h = 0; h < 16; ++h) { const float br = P.in[11][idx * 16 + h], bi = P.in[12][idx * 16 + h]; BBAR[idx * 16 + h] = make_float2(fr_ * br - fi_ * bi, fr_ * bi + fi_ * br); } }
            }
            grid.sync();
            (void)xcd_barrier_post(opq_tid(wid_s), BAR, bst);
        } else {
            if (bx < nkv || nkv == 0) {
                Order SK{}; SK.G = nkv ? nkv : G; SK.c = bx; SK.A = (const char*)MEMB; SK.B = (const char*)WKV; SK.tA = SK.tB = (size_t)BM * D_ * 2; SK.nM = 4; SK.nN = 16; SK.nZ = 1;
                EpiKV E{ssq_mem, KMAT, VT};
                gemm_phase(wid_s, lds, D_, D_, D_, false, SK, E);
            }
            xcd_barrier(wid_s, (unsigned*)(P.ws + WS_BAR), (volatile LAS unsigned*)(lds + STAGE_BYTES + 8192));
        }
    }
    if (PROBE == 3) { for (int r = 0; r < 10; ++r) xcd_barrier(wid_s, (unsigned*)(P.ws + WS_BAR), (volatile LAS unsigned*)(lds + STAGE_BYTES + 8192)); }
    {
        PHASE_TID;
        const float* c_re = P.in[13]; const float* c_im = P.in[14];
        for (int it = gt; it < 64 * 16 * 256; it += nth) { const int hi = it & 15, ho = (it >> 4) & 15, dl = (it >> 8) & 15, g = it >> 12; float s = 0.f;
            for (int p = 0; p < 64; ++p) { const float2 a = APOW[(g * 64 + p) * 17 + dl], b = BBAR[(g * 64 + p) * 16 + hi]; const float wr_ = a.x * b.x - a.y * b.y, wi_ = a.x * b.y + a.y * b.x;
                s += c_re[(g * 16 + ho) * 64 + p] * wr_ - c_im[(g * 16 + ho) * 64 + p] * wi_; }
            KM[it] = s; }
        for (int it = gt; it < 64 * 128 * 32; it += nth) { const int kc = it & 31, row = (it >> 5) & 127, g = it >> 12, p = row & 63, im = row >> 6, tau = kc >> 1, h0 = (kc & 1) * 8;
            const float2 a = APOW[(g * 64 + p) * 17 + 15 - tau]; f32x4 v0, v1;
#pragma unroll
            for (int e = 0; e < 8; ++e) { const float2 b = BBAR[(g * 64 + p) * 16 + h0 + e]; const float v = im ? (a.x * b.y + a.y * b.x) : (a.x * b.x - a.y * b.y); if (e < 4) v0[e] = v; else v1[e - 4] = v; }
            *(u32x4*)(PMAT + ((size_t)(g * 128 + row)) * 256 + kc * 8) = pack8(v0, v1); }
        for (int it = gt; it < 64 * 256 * 16; it += nth) { const int pc = it & 15, r = (it >> 4) & 255, g = it >> 12, tp = r >> 4, ho = r & 15, im = pc >> 3, p0 = (pc & 7) * 8; f32x4 v0, v1;
#pragma unroll
            for (int e = 0; e < 8; ++e) { const int p = p0 + e; const float2 a = APOW[(g * 64 + p) * 17 + tp + 1]; const float cr = c_re[(g * 16 + ho) * 64 + p], ci = c_im[(g * 16 + ho) * 64 + p];
                const float v = im ? -(cr * a.y + ci * a.x) : (cr * a.x - ci * a.y); if (e < 4) v0[e] = v; else v1[e - 4] = v; }
            *(u32x4*)(TQ + ((size_t)(g * 256 + r)) * 384 + 256 + pc * 8) = pack8(v0, v1); }
        __syncthreads();
        {
            const bool split = (G >= 256);
            for (int job = 0; job < 2; ++job) {
                if (split && ((bx >= 128) != (job == 1))) continue;
                Order SA{}; SA.G = split ? 128 : G; SA.c = split ? (bx & 127) : bx; SA.zsh = 2; SA.nZ = 16;
                if (job == 0) { SA.A = (const char*)KMAT; SA.zAhi = (size_t)256 * D_ * 2; SA.zAlo = 1024; SA.tA = 0; SA.B = (const char*)WQ; SA.zBhi = 0; SA.zBlo = 1024; SA.tB = (size_t)BM * D_ * 2; SA.nM = 1; SA.nN = 8; }
                else { SA.A = (const char*)WO; SA.zAhi = 0; SA.zAlo = 1024; SA.tA = (size_t)BM * D_ * 2; SA.B = (const char*)VT; SA.zBhi = (size_t)256 * D_ * 2; SA.zBlo = 1024; SA.tB = 0; SA.nM = 8; SA.nN = 1; }
                EpiStore EA{job ? VWT : MT, job ? 1024 : D_, job ? 1.0f : 0.044194173824159216f, job};
                gemm_phase(wid_s, lds, D_, D_, 512, false, SA, EA);
            }
        }
        S.A = (const char*)HB; S.B = (const char*)W1GU; S.zAhi = S.zAlo = S.zBhi = S.zBlo = 0; S.tA = (size_t)BM * D_ * 2; S.tB = (size_t)BM * D_ * 2; S.nM = 64; S.nN = 44; S.nZ = 1; S.zsh = 0; S.remap = 1;
        EpiGateUp E{ssq_x, ACT, (LAS float*)(lds + STAGE_BYTES)};
        gemm_phase(wid_s, lds, D_, D_, D_, false, S, E);
    }
    xcd_barrier(wid_s, (unsigned*)(P.ws + WS_BAR), (volatile LAS unsigned*)(lds + STAGE_BYTES + 8192));

    {
        PHASE_TID;
        for (int it = gt; it < 64 * 256 * 32; it += nth) { const int kc = it & 31, r = (it >> 5) & 255, g = it >> 13, tau = kc >> 1, hi0 = (kc & 1) * 8, tp = r >> 4, ho = r & 15;
            f32x4 v0 = {0.f, 0.f, 0.f, 0.f}, v1 = {0.f, 0.f, 0.f, 0.f};
            if (tp >= tau) { const float* kp = KM + ((g * 16 + tp - tau) * 16 + ho) * 16 + hi0; v0 = *(const f32x4*)kp; v1 = *(const f32x4*)(kp + 4); }
            *(u32x4*)(TQ + ((size_t)(g * 256 + r)) * 384 + kc * 8) = pack8(v0, v1); }
        __syncthreads();
        S.A = (const char*)ACT; S.B = (const char*)W1D; S.tA = (size_t)BM * FF_ * 2; S.tB = (size_t)BM * FF_ * 2; S.nM = 64; S.nN = 8; S.nZ = 1; S.remap = 1;
        EpiResid E{HB, ssq1, 0.5f};
        gemm_phase(wid_s, lds, FF_, FF_, FF_, false, S, E);
    }
    xcd_barrier(wid_s, (unsigned*)(P.ws + WS_BAR), (volatile LAS unsigned*)(lds + STAGE_BYTES + 8192));

    {
        S.A = (const char*)HB; S.B = (const char*)WIN; S.tA = S.tB = (size_t)BM * D_ * 2; S.nM = 64; S.nN = 8;
        EpiWin E{ssq1, APR, MRG, (LAS float*)(lds + STAGE_BYTES)};
        gemm_phase(wid_s, lds, D_, D_, D_, false, S, E);
    }
    xcd_barrier(wid_s, (unsigned*)(P.ws + WS_BAR), (volatile LAS unsigned*)(lds + STAGE_BYTES + 8192));

    {
        S.A = (const char*)APR; S.B = (const char*)PMAT; S.zAhi = (size_t)1024 * 384 * 2; S.zBhi = (size_t)128 * 256 * 2; S.tA = (size_t)BM * 384 * 2; S.tB = 0; S.nM = 4; S.nN = 1; S.nZ = 64; S.remap = 0;
        EpiSloc E{SLOC};
        gemm_phase(wid_s, lds, 384, 256, 256, true, S, E);
        if (G == 256) { __builtin_amdgcn_fence(__ATOMIC_ACQUIRE, "agent"); asm volatile("s_waitcnt vmcnt(0)" ::: "memory"); __syncthreads(); }
        else xcd_barrier(wid_s, (unsigned*)(P.ws + WS_BAR), (volatile LAS unsigned*)(lds + STAGE_BYTES + 8192));
        PHASE_TID;
        const int wid = tid >> 6, p = tid & 63; LAS float* endst = (LAS float*)(lds + STAGE_BYTES);
        for (int pair = bx; pair < 256; pair += G) { const int b = pair & 3, g = pair >> 2;
            const float2 a = APOW[(g * 64 + p) * 17 + 16];
            const float* sl = SLOC + ((size_t)(g * 1024 + b * 256 + wid * 32)) * 128;
            float xr[32], xi[32];
#pragma unroll
            for (int k = 0; k < 32; ++k) { xr[k] = sl[k * 128 + p]; xi[k] = sl[k * 128 + 64 + p]; }
            float sr = 0.f, si = 0.f;
#pragma unroll
            for (int k = 0; k < 32; ++k) { const float n_ = a.x * sr - a.y * si + xr[k]; si = a.x * si + a.y * sr + xi[k]; sr = n_; }
            float pr = a.x, pi = a.y;
#pragma unroll
            for (int q = 0; q < 5; ++q) { const float n_ = pr * pr - pi * pi; pi = 2.f * pr * pi; pr = n_; }
            endst[wid * 64 + p] = sr; endst[512 + wid * 64 + p] = si;
            __syncthreads();
            float cr = 0.f, ci = 0.f;
            for (int j = 0; j < wid; ++j) { const float ex = endst[j * 64 + p], ey = endst[512 + j * 64 + p]; const float n_ = pr * cr - pi * ci + ex; ci = pr * ci + pi * cr + ey; cr = n_; }
            bf16_t* ap = APR + ((size_t)(g * 1024 + b * 256 + wid * 32)) * 384 + 256;
            sr = cr; si = ci;
#pragma unroll
            for (int k = 0; k < 32; ++k) { const unsigned w = cvt_pk_bf16(sr, si); ap[k * 384 + p] = (bf16_t)(w & 0xffffu); ap[k * 384 + 64 + p] = (bf16_t)(w >> 16);
                const float n_ = a.x * sr - a.y * si + xr[k]; si = a.x * si + a.y * sr + xi[k]; sr = n_; }
            __syncthreads();
        }
        pooled_w<2>(MRG, APOOL, 0, gt, nth); pooled_w<4>(MRG, APOOL, 1, gt, nth); pooled_w<8>(MRG, APOOL, 2, gt, nth); pooled_w<16>(MRG, APOOL, 3, gt, nth);
    }
    xcd_barrier(wid_s, (unsigned*)(P.ws + WS_BAR), (volatile LAS unsigned*)(lds + STAGE_BYTES + 8192));

    {
        {
            S.A = (const char*)APR; S.B = (const char*)TQ; S.zAhi = (size_t)1024 * 384 * 2; S.zBhi = (size_t)256 * 384 * 2; S.tA = (size_t)BM * 384 * 2; S.tB = 0; S.nM = 4; S.nN = 1; S.nZ = 64; S.remap = 0;
            EpiY E{APR, P.in[15], YS};
            gemm_phase(wid_s, lds, 384, 384, 384, false, S, E);
        }
        {
            S.A = (const char*)APOOL; S.B = (const char*)WP; S.zAhi = 256 * 2; S.zBhi = (size_t)256 * 256 * 2; S.tA = (size_t)BM * 1024 * 2; S.tB = 0; S.nM = 64; S.nN = 1; S.nZ = 4; S.remap = 0;
            EpiPool E{P.in[19], MRG, ssq_pool};
            gemm_phase(wid_s, lds, 1024, 256, 256, false, S, E);
        }
    }
    xcd_barrier(wid_s, (unsigned*)(P.ws + WS_BAR), (volatile LAS unsigned*)(lds + STAGE_BYTES + 8192));

    {
        S.A = (const char*)YS; S.B = (const char*)WGLU; S.zAhi = S.zBhi = 0; S.tA = (size_t)BM * 32; S.tB = (size_t)BM * 1024 * 2; S.nM = 64; S.nN = 4; S.nZ = 1; S.remap = 1;
        EpiGlu E{YS, P.in[17], MRG, ssq_ssm};
        gemm_phase(wid_s, lds, 1024, 1024, 1024, false, S, E, true);
    }
    xcd_barrier(wid_s, (unsigned*)(P.ws + WS_BAR), (volatile LAS unsigned*)(lds + STAGE_BYTES + 8192));

    {
        const bool fuse2 = (512 % G) == 0;
        const int ncall = fuse2 ? 1 : P.two;
#pragma unroll 1
        for (int zz = 0; zz < ncall; ++zz) {
            S.A = (const char*)(MRG + (fuse2 ? 0 : zz * 1024)); S.B = (const char*)(WOUT + (fuse2 ? 0 : zz * 1024)); S.tA = S.tB = (size_t)BM * D_ * 2; S.nM = 64; S.nN = 8;
            S.nZ = fuse2 ? 2 : 1; S.zsh = 0; S.zAhi = 1024 * 2; S.zBhi = 1024 * 2; S.zAlo = S.zBlo = 0; S.remap = 1;
            EpiResid2 E{HB, ssq2, ssq_ssm, ssq_pool, fuse2 ? 0 : zz};
            gemm_phase(wid_s, lds, D_, D_, 1024, false, S, E);
            if (!fuse2 && zz == 0) xcd_barrier(wid_s, (unsigned*)(P.ws + WS_BAR), (volatile LAS unsigned*)(lds + STAGE_BYTES + 8192));
        }
        S.nZ = 1; S.zAhi = S.zBhi = 0;
    }
    xcd_barrier(wid_s, (unsigned*)(P.ws + WS_BAR), (volatile LAS unsigned*)(lds + STAGE_BYTES + 8192));

    {
        S.A = (const char*)HB; S.B = (const char*)MT; S.zsh = 2; S.zAhi = (size_t)4096 * D_ * 2; S.zAlo = 0; S.zBhi = (size_t)4 * 256 * D_ * 2; S.zBlo = (size_t)256 * D_ * 2; S.tA = (size_t)BM * D_ * 2; S.tB = 0; S.nM = 16; S.nN = 1; S.nZ = 16; S.remap = 0;
        EpiSoftmax E{ssq2, PMb, (LAS float*)(lds + STAGE_BYTES)};
        gemm_phase(wid_s, lds, D_, D_, D_, false, S, E);
    }
    xcd_barrier(wid_s, (unsigned*)(P.ws + WS_BAR), (volatile LAS unsigned*)(lds + STAGE_BYTES + 8192));

    {
        S.A = (const char*)PMb; S.B = (const char*)VWT; S.zsh = 0; S.zAhi = S.zAlo = S.zBhi = S.zBlo = 0; S.tA = (size_t)BM * 1024 * 2; S.tB = (size_t)BM * 1024 * 2; S.nM = 64; S.nN = 8; S.nZ = 1; S.remap = 1; S.bsh = 4; S.bstep = (size_t)2048 * 1024 * 2;
        EpiResid E{HB, ssq3, 1.0f};
        gemm_phase(wid_s, lds, 1024, 1024, 1024, false, S, E);
        S.bstep = 0; S.bsh = 0;
    }
    xcd_barrier(wid_s, (unsigned*)(P.ws + WS_BAR), (volatile LAS unsigned*)(lds + STAGE_BYTES + 8192));

    {
        S.A = (const char*)HB; S.B = (const char*)W2GU; S.tA = S.tB = (size_t)BM * D_ * 2; S.nM = 64; S.nN = 44;
        EpiGateUp E{ssq3, ACT, (LAS float*)(lds + STAGE_BYTES)};
        gemm_phase(wid_s, lds, D_, D_, D_, false, S, E);
        if (PROBE == 1) { xcd_barrier(wid_s, (unsigned*)(P.ws + WS_BAR), (volatile LAS unsigned*)(lds + STAGE_BYTES + 8192)); gemm_phase(wid_s, lds, D_, D_, D_, false, S, E); }
        if (PROBE == 5) {
            f32x4 pacc[32]; bf16x8 pa, pb;
#pragma unroll
            for (int i = 0; i < 32; ++i) pacc[i] = (f32x4){0.f, 0.f, 0.f, 0.f};
            { const int t9 = opq_tid(wid_s); const short v9 = (short)(0x3c00 + (t9 & 127));
#pragma unroll
              for (int i = 0; i < 8; ++i) { pa[i] = (short)(v9 + i * 3); pb[i] = (short)(v9 ^ (i * 5)); } }
#pragma unroll 1
            for (int it9 = 0; it9 < 11 * 32; ++it9) {
                __builtin_amdgcn_s_setprio(1);
#pragma unroll
                for (int r9 = 0; r9 < 2; ++r9)
#pragma unroll
                    for (int i = 0; i < 32; ++i) pacc[i] = __builtin_amdgcn_mfma_f32_16x16x32_bf16(pa, pb, pacc[i], 0, 0, 0);
                __builtin_amdgcn_s_setprio(0);
            }
            f32x4 s9 = {0.f, 0.f, 0.f, 0.f};
#pragma unroll
            for (int i = 0; i < 32; ++i) s9 += pacc[i];
            if (sum4(s9) == 12345.678f) ((float*)(P.ws + WS_KM))[0] = 1.0f;
        }
        if (PROBE == 9) { xcd_barrier(wid_s, (unsigned*)(P.ws + WS_BAR), (volatile LAS unsigned*)(lds + STAGE_BYTES + 8192)); Order S9 = S; EpiNull E9{(float*)(P.ws + WS_KM)}; gemm_phase(wid_s, lds, D_, D_, D_, false, S9, E9); }
        if (PROBE == 7) { xcd_barrier(wid_s, (unsigned*)(P.ws + WS_BAR), (volatile LAS unsigned*)(lds + STAGE_BYTES + 8192)); Order S9 = S; S9.tA = S9.tB = (size_t)BM * (D_ + 64) * 2; EpiNull E9{(float*)(P.ws + WS_KM)}; gemm_phase(wid_s, lds, D_ + 64, D_ + 64, D_, false, S9, E9); }
    }
    xcd_barrier(wid_s, (unsigned*)(P.ws + WS_BAR), (volatile LAS unsigned*)(lds + STAGE_BYTES + 8192));

    {
        S.A = (const char*)ACT; S.B = (const char*)W2D; S.tA = S.tB = (size_t)BM * FF_ * 2; S.nM = 64; S.nN = 8;
        EpiResid E{HB, ssq4, 0.5f};
        gemm_phase(wid_s, lds, FF_, FF_, FF_, false, S, E);
    }
    xcd_barrier(wid_s, (unsigned*)(P.ws + WS_BAR), (volatile LAS unsigned*)(lds + STAGE_BYTES + 8192));

    {
        PHASE_TID;
        const int lane = tid & 63, gw = bx * 8 + (tid >> 6), nw = G * 8; const f32x4* gf = (const f32x4*)P.in[33];
        for (int row = gw; row < T_; row += 2 * nw) {
            const bool has2 = (row + nw < T_); const int row2 = has2 ? row + nw : row;
            const float rs = rsqrtf(ssq4[row] * (1.0f / D_) + EPS_), rs2 = rsqrtf(ssq4[row2] * (1.0f / D_) + EPS_);
            const u32x4* hp = (const u32x4*)(HB + (size_t)row * D_); const u32x4* hp2 = (const u32x4*)(HB + (size_t)row2 * D_);
            f32x4* p = (f32x4*)(P.out + (size_t)row * D_); f32x4* p2 = (f32x4*)(P.out + (size_t)row2 * D_);
            u32x4 w[4], w2[4];
#pragma unroll
            for (int i = 0; i < 4; ++i) { w[i] = hp[lane + 64 * i]; w2[i] = hp2[lane + 64 * i]; }
#pragma unroll
            for (int i = 0; i < 4; ++i) { f32x4 a, b; const int c4 = (lane + 64 * i) * 2; const f32x4 g0 = gf[c4], g1 = gf[c4 + 1];
                unpack8(w[i], a, b); p[c4] = a * rs * g0; p[c4 + 1] = b * rs * g1;
                unpack8(w2[i], a, b); if (has2) { p2[c4] = a * rs2 * g0; p2[c4 + 1] = b * rs2 * g1; } } }
    }
}

extern "C" void kernel_launch(void* const* d_in, const int* in_sizes, int n_in, void* d_out, int out_size, void* d_ws, size_t ws_size, hipStream_t stream) {
    static int grid_blocks = 0;
    if (!grid_blocks) {
        if (n_in != 34 || out_size != T_ * D_ || ws_size < WS_END) { fprintf(stderr, "kernel_launch: unexpected shapes (n_in %d out %d ws %zu need %zu)\n", n_in, out_size, ws_size, (size_t)WS_END); grid_blocks = -1; return; }
        int dev = 0, cus = 0, per_cu = 0;
        (void)hipGetDevice(&dev);
        (void)hipDeviceGetAttribute(&cus, hipDeviceAttributeMultiprocessorCount, dev);
        if (hipFuncSetAttribute((const void*)mega, hipFuncAttributeMaxDynamicSharedMemorySize, LDS_BYTES) != hipSuccess) { fprintf(stderr, "hipFuncSetAttribute failed\n"); grid_blocks = -1; return; }
        (void)hipOccupancyMaxActiveBlocksPerMultiprocessor(&per_cu, (const void*)mega, 512, LDS_BYTES);
        if (per_cu < 1) per_cu = 1;
        grid_blocks = cus * per_cu;
    }
    if (grid_blocks < 0) return;
    Params p{};
    for (int i = 0; i < 34; ++i) p.in[i] = (const float*)d_in[i];
    p.out = (float*)d_out; p.ws = (unsigned char*)d_ws; p.two = 2; p.pad = 0;
    void* args[] = {&p};
    hipError_t e = hipLaunchCooperativeKernel((const void*)mega, dim3(grid_blocks), dim3(512), args, LDS_BYTES, stream);
    if (e != hipSuccess) fprintf(stderr, "cooperative launch failed: %s (grid %d)\n", hipGetErrorString(e), grid_blocks);
}
```

```cpp
#include <hip/hip_runtime.h>
#include <hip/hip_cooperative_groups.h>
#include <cstdio>
namespace cg = cooperative_groups;

#define LAS __attribute__((address_space(3)))
typedef unsigned short bf16_t;
typedef short bf16x8 __attribute__((ext_vector_type(8)));
typedef float f32x4 __attribute__((ext_vector_type(4)));
typedef unsigned u32x4 __attribute__((ext_vector_type(4)));
typedef unsigned u32x2 __attribute__((ext_vector_type(2)));

__device__ __forceinline__ int lane_fresh() { int l; asm volatile("v_mbcnt_lo_u32_b32 %0, -1, 0\n\tv_mbcnt_hi_u32_b32 %0, -1, %0" : "=v"(l)); return l; }
__device__ __forceinline__ int opq_tid(int wid_s) { return wid_s * 64 + lane_fresh(); }
__device__ __forceinline__ float xshfl(float v, int idx4) { return __int_as_float(__builtin_amdgcn_ds_bpermute(idx4, __float_as_int(v))); }
#ifndef PROBE
#define PROBE 0
#endif
#define PROBE_IS(n) (PROBE == (n))
constexpr int T_ = 16384, D_ = 2048, FF_ = 5632;
constexpr float EPS_ = 1e-6f;
constexpr int BM = 256, BK = 64, HALF = 128, HTB = HALF * BK * 2, STAGE_BYTES = 8 * HTB, NXCD = 8, WGM = 8;
constexpr int LDS_BYTES = STAGE_BYTES + 8192 + 16;

constexpr size_t SZ_WGU = (size_t)2 * FF_ * D_ * 2, SZ_WD = (size_t)D_ * FF_ * 2, SZ_SQ = (size_t)D_ * D_ * 2;
constexpr size_t WS_W1GU = 0;
constexpr size_t WS_W1D = WS_W1GU + SZ_WGU;
constexpr size_t WS_W2GU = WS_W1D + SZ_WD;
constexpr size_t WS_W2D = WS_W2GU + SZ_WGU;
constexpr size_t WS_WIN = WS_W2D + SZ_WD;
constexpr size_t WS_WOUT = WS_WIN + SZ_SQ;
constexpr size_t WS_WQ = WS_WOUT + SZ_SQ;
constexpr size_t WS_WO = WS_WQ + SZ_SQ;
constexpr size_t WS_WKV = WS_WO + SZ_SQ;
constexpr size_t WS_WGLU = WS_WKV + 2 * SZ_SQ;
constexpr size_t WS_WP = WS_WGLU + (size_t)1024 * 1024 * 2;
constexpr size_t WS_PMAT = WS_WP + (size_t)4 * 256 * 256 * 2;
constexpr size_t WS_TQ = WS_PMAT + (size_t)64 * 128 * 256 * 2;
constexpr size_t WS_APOW = WS_TQ + (size_t)64 * 256 * 384 * 2;
constexpr size_t WS_BBAR = WS_APOW + (size_t)4096 * 17 * 8;
constexpr size_t WS_KM = WS_BBAR + (size_t)4096 * 16 * 8;
constexpr size_t WS_MEMB = WS_KM + (size_t)64 * 16 * 256 * 4;
constexpr size_t WS_KMAT = WS_MEMB + (size_t)1024 * 2048 * 2;
constexpr size_t WS_VT = WS_KMAT + (size_t)1024 * 2048 * 2;
constexpr size_t WS_HB = WS_VT + (size_t)1024 * 2048 * 2;
constexpr size_t WS_SSQ = WS_HB + (size_t)T_ * D_ * 2;
constexpr size_t WS_BAR = WS_SSQ + (size_t)8 * T_ * 4;
constexpr size_t WS_X = WS_BAR + 16384;
constexpr size_t X_ACT = 0;
constexpr size_t X_APR = 0;
constexpr size_t X_MRG = X_APR + (size_t)64 * 1024 * 384 * 2;
constexpr size_t X_APOOL = X_MRG + (size_t)T_ * 2048 * 2;
constexpr size_t X_SLOC = X_APOOL + (size_t)T_ * 1024 * 2;
constexpr size_t X_YS = X_SLOC;
constexpr size_t X_P = 0;
constexpr size_t WS_MT = WS_X + (size_t)T_ * FF_ * 2;
constexpr size_t WS_VWT = WS_MT + (size_t)16 * 256 * 2048 * 2;
constexpr size_t WS_END = WS_VWT + (size_t)4 * 2048 * 1024 * 2;
static_assert(X_SLOC + (size_t)64 * 1024 * 128 * 4 <= (size_t)T_ * FF_ * 2, "mixer scratch fits the act region");


#define XB_TMO      128
#define XB_XCNT(j)  (256  + 64 * (j))
#define XB_XSUB(j)  (1280 + 64 * (j))
#define XB_XGEN(j)  (2304 + 64 * (j))
#define XB_TOP      3328
#define XB_TOPGEN   3392
#define XCD_BAR_WORDS 3456
#define XB_SPIN_CAP (1u << 22)
__device__ __forceinline__ unsigned xb_ld(unsigned* p)              { return __hip_atomic_load(p, __ATOMIC_RELAXED, __HIP_MEMORY_SCOPE_AGENT); }
__device__ __forceinline__ unsigned xb_add(unsigned* p, unsigned v) { return __hip_atomic_fetch_add(p, v, __ATOMIC_RELAXED, __HIP_MEMORY_SCOPE_AGENT); }
__device__ __forceinline__ unsigned xb_xcc_id() { return (unsigned)__builtin_amdgcn_s_getreg((3 << 11) | 20) & 0xFu; }
#define XB_SPIN(cond, bar) do { unsigned _sp = 0; while (cond) { __builtin_amdgcn_s_sleep(1); \
    if ((++_sp & 255u) == 0u) { if (xb_ld(&(bar)[XB_TMO])) break; if (_sp > XB_SPIN_CAP) { atomicAdd(&(bar)[XB_TMO], 1u); break; } } } } while (0)
struct XcdBarrier { unsigned* bar; unsigned x; volatile LAS unsigned* st; };
__device__ __forceinline__ XcdBarrier xcd_barrier_post(const int tid, unsigned* bar, volatile LAS unsigned* st) {
    XcdBarrier b; b.bar = bar; b.x = xb_xcc_id(); b.st = st;
    if (tid == 0) (void)xb_add(&bar[XB_XCNT(b.x)], 1u);
    return b;
}
__device__ __forceinline__ void xcd_barrier_complete(unsigned* bar, unsigned x, unsigned& nloc, unsigned& nx) {
    const unsigned G = gridDim.x * gridDim.y * gridDim.z;
    unsigned sum, cnt, mine, sp = 0u;
    for (;;) {
        sum = 0u; cnt = 0u; mine = 0u;
#pragma unroll
        for (unsigned j = 0; j < 16; ++j) { const unsigned c = xb_ld(&bar[XB_XCNT(j)]); sum += c; cnt += (c > 0u) ? 1u : 0u; mine = (j == x) ? c : mine; }
        if (sum == G) break;
        __builtin_amdgcn_s_sleep(1);
        if ((++sp & 255u) == 0u) { if (xb_ld(&bar[XB_TMO])) break; if (sp > XB_SPIN_CAP) { atomicAdd(&bar[XB_TMO], 1u); break; } }
    }
    nloc = mine > 0u ? mine : 1u; nx = cnt > 0u ? cnt : 1u;
}
__device__ __forceinline__ void xcd_barrier(const int wid_s, unsigned* bar_, volatile LAS unsigned* st_) {
    const int tid0 = opq_tid(wid_s);
    XcdBarrier b; b.bar = bar_; b.st = st_; b.x = xb_xcc_id();
    asm volatile("s_waitcnt vmcnt(0)" ::: "memory");
    __syncthreads();
    if (tid0 == 0) {
        unsigned* bar = b.bar;
        __builtin_amdgcn_s_waitcnt(0);
        unsigned nloc = b.st[0], nx = b.st[1];
        if (nloc == 0u) { xcd_barrier_complete(bar, b.x, nloc, nx); b.st[0] = nloc; b.st[1] = nx; }
        const unsigned old = xb_add(&bar[XB_XSUB(b.x)], 1u);
        const unsigned gen = old / nloc;
        if (old + 1u == (gen + 1u) * nloc) {
            __builtin_amdgcn_fence(__ATOMIC_RELEASE, "agent");
            asm volatile("s_waitcnt vmcnt(0)" ::: "memory");
            const unsigned og = xb_add(&bar[XB_TOP], 1u);
            const unsigned tg = og / nx;
            if (og + 1u == (tg + 1u) * nx) xb_add(&bar[XB_TOPGEN], 1u);
            else XB_SPIN(xb_ld(&bar[XB_TOPGEN]) == tg, bar);
            __builtin_amdgcn_fence(__ATOMIC_ACQUIRE, "agent");
            xb_add(&bar[XB_XGEN(b.x)], 1u);
            asm volatile("s_waitcnt vmcnt(0)" ::: "memory");
        } else {
            XB_SPIN(xb_ld(&bar[XB_XGEN(b.x)]) == gen, bar);
            __builtin_amdgcn_fence(__ATOMIC_ACQUIRE, "agent");
            asm volatile("s_waitcnt vmcnt(0)" ::: "memory");
        }
    }
    __syncthreads();
}

struct Params { const float* in[34]; float* out; unsigned char* ws; int two; int pad; };

__device__ __forceinline__ unsigned cvt_pk_bf16(float lo, float hi) { unsigned r; asm("v_cvt_pk_bf16_f32 %0, %1, %2" : "=v"(r) : "v"(lo), "v"(hi)); return r; }
__device__ __forceinline__ u32x4 pack8(f32x4 a, f32x4 b) { u32x4 w; w.x = cvt_pk_bf16(a[0], a[1]); w.y = cvt_pk_bf16(a[2], a[3]); w.z = cvt_pk_bf16(b[0], b[1]); w.w = cvt_pk_bf16(b[2], b[3]); return w; }
__device__ __forceinline__ void unpack8(u32x4 w, f32x4& a, f32x4& b) {
    a[0] = __uint_as_float(w.x << 16); a[1] = __uint_as_float(w.x & 0xffff0000u); a[2] = __uint_as_float(w.y << 16); a[3] = __uint_as_float(w.y & 0xffff0000u);
    b[0] = __uint_as_float(w.z << 16); b[1] = __uint_as_float(w.z & 0xffff0000u); b[2] = __uint_as_float(w.w << 16); b[3] = __uint_as_float(w.w & 0xffff0000u);
}
__device__ __forceinline__ float fast_sigmoid(float x) { return __builtin_amdgcn_rcpf(1.0f + __expf(-x)); }
__device__ __forceinline__ float sum4(f32x4 v) { return (v[0] + v[1]) + (v[2] + v[3]); }
__device__ __forceinline__ float sumsq4(f32x4 v) { return (v[0] * v[0] + v[1] * v[1]) + (v[2] * v[2] + v[3] * v[3]); }
__device__ __forceinline__ float max4(f32x4 v) { return fmaxf(fmaxf(v[0], v[1]), fmaxf(v[2], v[3])); }

__device__ __forceinline__ int lds_byte(int r, int c) { const int st = (r >> 4) * 2 + (c >> 5), rr = r & 15, cc = c & 31, ob = rr * 64 + cc * 2; return st * 1024 + (ob ^ (((ob >> 9) & 1) << 5)); }
__device__ __forceinline__ void stage_rc(int b, int& R, int& C) { const int st = b / 1024, sb = b % 1024, swz = sb ^ (((sb >> 9) & 1) << 5); R = (st >> 1) * 16 + swz / 64; C = (st & 1) * 32 + (swz % 64) / 2; }
__device__ __forceinline__ int perm32(int rho) { const int n = rho >> 4, i = rho & 15; return 8 * (i >> 2) + 4 * n + (i & 3); }

struct Unit { const char* A; const char* B; int pm, pn, z, par; };

struct Order {
    const char* A; const char* B; size_t zAhi, zAlo, zBhi, zBlo, tA, tB; int nM, nN, nZ, zsh, remap, G, c;
    const char* A2; const char* B2; size_t tA2, tB2; int nM2, nN2;
    int bsh; size_t bstep;
    __device__ __forceinline__ bool next(int i, Unit& u) const {
        long L = (long)i * G + c; const int per = nM * nN; const long tot = (long)per * nZ;
        if (L < tot) {
            const int z = (int)(L / per); int wgid = (int)(L % per), pm, pn;
            if (remap) {
                const int nwg = per; { const int q = nwg / NXCD, r = nwg % NXCD, xcd = wgid % NXCD, off = wgid / NXCD; wgid = (xcd < r ? xcd * (q + 1) : r * (q + 1) + (xcd - r) * q) + off; }
                const int nig = WGM * nN, gid = wgid / nig, fm = gid * WGM, gsz = (nM - fm) < WGM ? (nM - fm) : WGM;
                pm = fm + ((wgid % nig) % gsz); pn = (wgid % nig) / gsz;
            } else { pm = wgid % nM; pn = wgid / nM; }
            const int zh = z >> zsh, zl = z & ((1 << zsh) - 1);
            u.pm = pm; u.pn = pn; u.z = z; u.A = A + zh * zAhi + zl * zAlo + pm * tA; u.B = B + zh * zBhi + zl * zBlo + pn * tB + (size_t)(pm >> bsh) * bstep; return true;
        }
        L -= tot;
        if (L < (long)nM2 * nN2) { const int pm = (int)(L % nM2), pn = (int)(L / nM2); u.pm = pm; u.pn = pn; u.z = -1; u.A = A2 + pm * tA2; u.B = B2 + pn * tB2; return true; }
        return false;
    }
};

typedef f32x4 (&AccRef)[2][2][4][2];
#define FOR_AM _Pragma("unroll") for (int ai = 0; ai < 2; ++ai) _Pragma("unroll") for (int m = 0; m < 4; ++m)
#define FOR_BJ _Pragma("unroll") for (int bj = 0; bj < 2; ++bj)

template <class Epi>
__device__ __forceinline__ void gemm_phase(const int wid_s, LAS unsigned char* lds, const int lda, const int ldb, const int K, const bool bdup, const Order& S, const Epi& E, const bool agm = false) {
    const int tid = opq_tid(wid_s), wid = wid_s, lane = tid & 63, wr = wid >> 2, wc = wid & 3, fr = lane & 15, fq = lane >> 4;
    const int nt = K / BK;
    unsigned voffA[2], voffB[2];
#pragma unroll
    for (int i = 0; i < 2; ++i) { int R, C; stage_rc(tid * 16 + i * 8192, R, C); const int Rb = (R & ~31) + perm32(R & 31);
        voffA[i] = agm ? (unsigned)((C >> 4) * (T_ * 16) + R * 16 + (C & 15)) * 2u : (unsigned)(R * lda + C) * 2u; voffB[i] = (unsigned)(Rb * ldb + C) * 2u; }
    const size_t kstep = (size_t)(BK * 2), kstepA = agm ? (size_t)4 * T_ * 32 : kstep;
    const size_t hstepA = agm ? (size_t)HALF * 32 : (size_t)HALF * lda * 2, hstepB = bdup ? (size_t)0 : (size_t)HALF * ldb * 2;
    const unsigned ldsw = (unsigned)wid * 1024u;
    const int aoff = lds_byte(wr * 64 + fr, fq * 8), boff = lds_byte(wc * 32 + fr, fq * 8);
#define PG8_SA(b, h) (((b) * 2 + (h)) * HTB)
#define PG8_SB(b, h) ((4 + (b) * 2 + (h)) * HTB)
#define PG8_STAGE(bufoff, gbase, voff) do { _Pragma("unroll") for (int _i = 0; _i < 2; ++_i) \
        __builtin_amdgcn_global_load_lds((const unsigned*)((const char*)(gbase) + (voff)[_i]), (LAS unsigned*)(lds + (bufoff) + ldsw + _i * 8192), 16, 0, 0); } while (0)
#define PG8_LDA(dst, b, h) do { _Pragma("unroll") for (int m = 0; m < 4; ++m) _Pragma("unroll") for (int k = 0; k < 2; ++k) dst[m][k] = *(const LAS bf16x8*)(lds + PG8_SA(b, h) + aoff + m * 2048 + k * 1024); } while (0)
#define PG8_LDB(dst, b, h) do { _Pragma("unroll") for (int n = 0; n < 2; ++n) _Pragma("unroll") for (int k = 0; k < 2; ++k) dst[n][k] = *(const LAS bf16x8*)(lds + PG8_SB(b, h) + boff + n * 2048 + k * 1024); } while (0)
#define PG8_MMA(ai, bj, At, Bt) do { __builtin_amdgcn_s_setprio(1); _Pragma("unroll") for (int m = 0; m < 4; ++m) _Pragma("unroll") for (int n = 0; n < 2; ++n) _Pragma("unroll") for (int k = 0; k < 2; ++k) \
        acc[ai][bj][m][n] = __builtin_amdgcn_mfma_f32_16x16x32_bf16(Bt[n][k], At[m][k], acc[ai][bj][m][n], 0, 0, 0); __builtin_amdgcn_s_setprio(0); } while (0)
#define PG8_WAIT_V(n) asm volatile("s_waitcnt vmcnt(" #n ")" ::: "memory")
#define PG8_WAIT_L(n) asm volatile("s_waitcnt lgkmcnt(" #n ")" ::: "memory")
#define PG8_BAR __builtin_amdgcn_s_barrier()
#define PG8_SCHED __builtin_amdgcn_sched_barrier(0)
    Unit cur, nxt; int ui = 0;
    if (!S.next(0, cur)) return;
    f32x4 acc[2][2][4][2];
#pragma unroll
    for (int a = 0; a < 2; ++a)
#pragma unroll
        for (int b = 0; b < 2; ++b)
#pragma unroll
            for (int m = 0; m < 4; ++m)
#pragma unroll
                for (int n = 0; n < 2; ++n) acc[a][b][m][n] = (f32x4){0.f, 0.f, 0.f, 0.f};
    bf16x8 At[4][2], B0[2][2], B1[2][2];
    const char* cA = cur.A; const char* cB = cur.B; cur.par = 0;
    if constexpr (Epi::PRE) E.prefetch(cur, tid);
    PG8_STAGE(PG8_SB(0, 0), cB, voffB); PG8_STAGE(PG8_SA(0, 0), cA, voffA); PG8_STAGE(PG8_SB(0, 1), cB + hstepB, voffB); PG8_STAGE(PG8_SA(0, 1), cA + hstepA, voffA);
    if (wr == 1) PG8_BAR;
    PG8_WAIT_V(4); PG8_BAR;
    PG8_STAGE(PG8_SB(1, 0), cB + kstep, voffB); PG8_STAGE(PG8_SA(1, 0), cA + kstepA, voffA); PG8_STAGE(PG8_SB(1, 1), cB + hstepB + kstep, voffB);
    PG8_WAIT_V(6); PG8_BAR;
    for (;;) {
        const bool has_next = S.next(ui + 1, nxt); nxt.par = (ui + 1) & 1;
        const char* nA = has_next ? nxt.A : cA; const char* nB = has_next ? nxt.B : cB;
#pragma unroll 1
        for (int t = 0; t < nt; t += 2) {
            const bool last = (t == nt - 2);
            const char* a1 = cA + (size_t)(t + 1) * kstepA;
            const char* a2 = last ? nA : cA + (size_t)(t + 2) * kstepA; const char* b2 = last ? nB : cB + (size_t)(t + 2) * kstep;
            const char* a3 = a2 + kstepA; const char* b3 = b2 + kstep;
            PG8_LDB(B0, 0, 0); PG8_SCHED; PG8_LDA(At, 0, 0); PG8_STAGE(PG8_SA(1, 1), a1 + hstepA, voffA);
            PG8_WAIT_L(8); PG8_BAR; PG8_WAIT_L(0); PG8_MMA(0, 0, At, B0); PG8_BAR; PG8_SCHED;
            PG8_LDB(B1, 0, 1); PG8_STAGE(PG8_SB(0, 0), b2, voffB);
            PG8_BAR; PG8_WAIT_L(0); PG8_MMA(0, 1, At, B1); PG8_BAR;
            PG8_LDA(At, 0, 1); PG8_STAGE(PG8_SA(0, 0), a2, voffA);
            PG8_BAR; PG8_WAIT_L(0); PG8_MMA(1, 0, At, B0); PG8_BAR; PG8_SCHED;
            PG8_STAGE(PG8_SB(0, 1), b2 + hstepB, voffB);
            PG8_WAIT_V(6); PG8_BAR; PG8_MMA(1, 1, At, B1); PG8_BAR;
            PG8_LDB(B0, 1, 0); PG8_SCHED; PG8_LDA(At, 1, 0); PG8_STAGE(PG8_SA(0, 1), a2 + hstepA, voffA);
            PG8_WAIT_L(8); PG8_BAR; PG8_WAIT_L(0); PG8_MMA(0, 0, At, B0); PG8_BAR; PG8_SCHED;
            PG8_LDB(B1, 1, 1); PG8_STAGE(PG8_SB(1, 0), b3, voffB);
            PG8_BAR; PG8_WAIT_L(0); PG8_MMA(0, 1, At, B1); PG8_BAR;
            PG8_LDA(At, 1, 1); PG8_STAGE(PG8_SA(1, 0), a3, voffA);
            PG8_BAR; PG8_WAIT_L(0); PG8_MMA(1, 0, At, B0); PG8_BAR; PG8_SCHED;
            PG8_STAGE(PG8_SB(1, 1), b3 + hstepB, voffB);
            PG8_WAIT_V(6); PG8_BAR; PG8_MMA(1, 1, At, B1); PG8_BAR;
        }
        { int fr_e = fr, fq_e = fq; asm volatile("" : "+v"(fr_e), "+v"(fq_e));
          E(acc, cur, wr, wc, fr_e, fq_e);
          if constexpr (Epi::PRE) { if (has_next) { int t_e = tid; asm volatile("" : "+v"(t_e)); E.prefetch(nxt, t_e); } } }
        if (!has_next) break;
#pragma unroll
        for (int a = 0; a < 2; ++a)
#pragma unroll
            for (int b = 0; b < 2; ++b)
#pragma unroll
                for (int m = 0; m < 4; ++m)
#pragma unroll
                    for (int n = 0; n < 2; ++n) acc[a][b][m][n] = (f32x4){0.f, 0.f, 0.f, 0.f};
        cur = nxt; cA = nA; cB = nB; ++ui;
    }
    PG8_WAIT_V(0);
    if (wr == 0) PG8_BAR;
    PG8_BAR;
#undef PG8_SA
#undef PG8_SB
#undef PG8_STAGE
#undef PG8_LDA
#undef PG8_LDB
#undef PG8_MMA
#undef PG8_WAIT_V
#undef PG8_WAIT_L
#undef PG8_BAR
#undef PG8_SCHED
}

#define ATOMIC_ROWS(ssq_out_, row0_, fq_, ssv_) do { \
    const float v0_ = ((fq_) == 0) ? ssv_[0][0] : ((fq_) == 1) ? ssv_[0][1] : ((fq_) == 2) ? ssv_[0][2] : ssv_[0][3]; \
    const float v1_ = ((fq_) == 0) ? ssv_[1][0] : ((fq_) == 1) ? ssv_[1][1] : ((fq_) == 2) ? ssv_[1][2] : ssv_[1][3]; \
    unsafeAtomicAdd((ssq_out_) + (row0_) + (fq_) * 16, v0_); unsafeAtomicAdd((ssq_out_) + (row0_) + HALF + (fq_) * 16, v1_); } while (0)


typedef float f32x2 __attribute__((ext_vector_type(2)));
struct EpiGateUp {
    static constexpr bool MID = false, PRE = true;
    const float* ssq; bf16_t* act; LAS float* tab;
    __device__ __forceinline__ void prefetch(const Unit& u, int tid) const {
        if (tid < 256) tab[u.par * 256 + tid] = rsqrtf(ssq[u.pm * BM + tid] * (1.0f / D_) + EPS_);
    }
    __device__ __forceinline__ void operator()(AccRef acc, const Unit& u, int wr, int wc, int fr, int fq) const {
        const int colt = wc * 32 + fq * 8, row0 = u.pm * BM + wr * 64 + fr;
        const LAS float* tp = tab + u.par * 256 + wr * 64 + fr;
        for (int rep_ = 0; rep_ < (PROBE == 8 ? 2 : 1); ++rep_)
        FOR_AM { const int row = row0 + ai * HALF + m * 16; const float rs = tp[ai * HALF + m * 16]; const float c = -1.4426950408889634f * rs, rs2 = rs * rs;
            u32x4 w;
#pragma unroll
            for (int n = 0; n < 2; ++n)
#pragma unroll
                for (int h = 0; h < 2; ++h) { const f32x2 g = {acc[ai][0][m][n][2 * h], acc[ai][0][m][n][2 * h + 1]}, uu = {acc[ai][1][m][n][2 * h], acc[ai][1][m][n][2 * h + 1]};
                    const f32x2 t = g * c; f32x2 e; e.x = __builtin_amdgcn_exp2f(t.x); e.y = __builtin_amdgcn_exp2f(t.y);
                    const f32x2 d = e + 1.0f; f32x2 r; r.x = __builtin_amdgcn_rcpf(d.x); r.y = __builtin_amdgcn_rcpf(d.y);
                    const f32x2 o = (g * uu) * (r * rs2);
                    w[n * 2 + h] = cvt_pk_bf16(o.x, o.y); }
            *(u32x4*)(act + (size_t)row * FF_ + u.pn * HALF + colt) = w; }
    }
};

struct EpiKV {
    static constexpr bool MID = false, PRE = false;
    const float* ssq_m; bf16_t* kmat; bf16_t* vmat;
    __device__ __forceinline__ void operator()(AccRef acc, const Unit& u, int wr, int wc, int fr, int fq) const {
        const int colt = wc * 32 + fq * 8, row0 = u.pm * BM + wr * 64 + fr;
        bf16_t* dst = (u.pn < 8) ? kmat : vmat; const int pnl = u.pn & 7;
        float rsv[2][4];
        FOR_AM rsv[ai][m] = ssq_m[row0 + ai * HALF + m * 16];
        FOR_AM { const int row = row0 + ai * HALF + m * 16; const float rs = rsqrtf(rsv[ai][m] * (1.0f / D_) + EPS_);
            FOR_BJ *(u32x4*)(dst + (size_t)row * D_ + pnl * BM + bj * HALF + colt) = pack8(acc[ai][bj][m][0] * rs, acc[ai][bj][m][1] * rs); }
    }
};

struct EpiStore {
    static constexpr bool MID = false, PRE = false;
    bf16_t* out; int ld; float scale; int mode;
    __device__ __forceinline__ void operator()(AccRef acc, const Unit& u, int wr, int wc, int fr, int fq) const {
        const int colt = wc * 32 + fq * 8, rl0 = wr * 64 + fr;
        const int rowbase = mode ? ((u.z >> 2) * 2048 + u.pm * BM) : (u.z * 256), colbase = mode ? ((u.z & 3) * 256) : (u.pn * BM);
        FOR_AM { const int row = rowbase + rl0 + ai * HALF + m * 16;
            FOR_BJ *(u32x4*)(out + (size_t)row * ld + colbase + bj * HALF + colt) = pack8(acc[ai][bj][m][0] * scale, acc[ai][bj][m][1] * scale); }
    }
};

struct EpiResid {
    static constexpr bool MID = false, PRE = false;
    bf16_t* hb; float* ssq_out; float alpha;
    __device__ __forceinline__ void operator()(AccRef acc, const Unit& u, int wr, int wc, int fr, int fq) const {
        const int L_ = lane_fresh(), i16 = (L_ ^ 16) << 2, i32 = (L_ ^ 32) << 2;
        const int colt = wc * 32 + fq * 8, row0 = u.pm * BM + wr * 64 + fr;
        bf16_t* base = hb + (size_t)row0 * D_ + u.pn * BM + colt;
        u32x4 rr[2][4][2];
        FOR_AM { FOR_BJ rr[ai][m][bj] = *(const u32x4*)(base + (size_t)(ai * HALF + m * 16) * D_ + bj * HALF); }
        float ssv[2][4];
        FOR_AM { float ss = 0.f;
            FOR_BJ { f32x4 r0, r1; unpack8(rr[ai][m][bj], r0, r1);
                const f32x4 h0 = r0 + acc[ai][bj][m][0] * alpha, h1 = r1 + acc[ai][bj][m][1] * alpha;
                *(u32x4*)(base + (size_t)(ai * HALF + m * 16) * D_ + bj * HALF) = pack8(h0, h1); ss += sumsq4(h0) + sumsq4(h1); }
            ss += xshfl(ss, i16); ss += xshfl(ss, i32); ssv[ai][m] = ss; }
        ATOMIC_ROWS(ssq_out, row0, fq, ssv);
    }
};

struct EpiResid2 {
    static constexpr bool MID = false, PRE = false;
    bf16_t* hb; float* ssq_out; const float* ssq_s; const float* ssq_p; int zbase;
    __device__ __forceinline__ void operator()(AccRef acc, const Unit& u, int wr, int wc, int fr, int fq) const {
        const int L_ = lane_fresh(), i16 = (L_ ^ 16) << 2, i32 = (L_ ^ 32) << 2;
        const int colt = wc * 32 + fq * 8, row0 = u.pm * BM + wr * 64 + fr, half = u.z + zbase;
        const float* sq = half ? ssq_p : ssq_s;
        bf16_t* base = hb + (size_t)row0 * D_ + u.pn * BM + colt;
        float rsv[2][4]; u32x4 rr[2][4][2];
        FOR_AM rsv[ai][m] = sq[row0 + ai * HALF + m * 16];
        FOR_AM { FOR_BJ rr[ai][m][bj] = *(const u32x4*)(base + (size_t)(ai * HALF + m * 16) * D_ + bj * HALF); }
        float ssv[2][4];
        FOR_AM { const float rs = rsqrtf(rsv[ai][m] * (1.0f / 1024) + EPS_); float ss = 0.f;
            FOR_BJ { f32x4 r0, r1; unpack8(rr[ai][m][bj], r0, r1);
                const f32x4 h0 = r0 + acc[ai][bj][m][0] * rs, h1 = r1 + acc[ai][bj][m][1] * rs;
                *(u32x4*)(base + (size_t)(ai * HALF + m * 16) * D_ + bj * HALF) = pack8(h0, h1); ss += sumsq4(h0) + sumsq4(h1); }
            ss += xshfl(ss, i16); ss += xshfl(ss, i32); ssv[ai][m] = ss; }
        if (half == 1) ATOMIC_ROWS(ssq_out, row0, fq, ssv);
    }
};

struct EpiWin {
    static constexpr bool MID = false, PRE = true;
    const float* ssq; bf16_t* apr; bf16_t* mrg; LAS float* tab;
    __device__ __forceinline__ void prefetch(const Unit& u, int tid) const {
        if (tid < 256) tab[u.par * 256 + tid] = rsqrtf(ssq[u.pm * BM + tid] * (1.0f / D_) + EPS_);
    }
    __device__ __forceinline__ void operator()(AccRef acc, const Unit& u, int wr, int wc, int fr, int fq) const {
        const int colt = wc * 32 + fq * 8, row0 = u.pm * BM + wr * 64 + fr;
        const LAS float* tp = tab + u.par * 256 + wr * 64 + fr;
        FOR_AM { const int row = row0 + ai * HALF + m * 16; const float rs = tp[ai * HALF + m * 16];
            FOR_BJ { const int gc = u.pn * BM + bj * HALF + colt; const u32x4 w = pack8(acc[ai][bj][m][0] * rs, acc[ai][bj][m][1] * rs);
                if (gc < 1024) { const int g = gc >> 4, h0 = gc & 15, n = row >> 4, tau = row & 15;
                    *(u32x4*)(apr + ((size_t)(g * 1024 + n)) * 384 + tau * 16 + h0) = w; }
                else *(u32x4*)(mrg + (size_t)row * D_ + gc) = w; } }
    }
};

struct EpiSloc {
    static constexpr bool MID = false, PRE = false;
    float* sloc;
    __device__ __forceinline__ void operator()(AccRef acc, const Unit& u, int wr, int wc, int fr, int fq) const {
        const int colt = wc * 32 + fq * 8, row0 = u.pm * BM + wr * 64 + fr;
        FOR_AM { const int n = row0 + ai * HALF + m * 16; float* p = sloc + ((size_t)(u.z * 1024 + n)) * 128 + colt;
            *(f32x4*)p = acc[ai][0][m][0]; *(f32x4*)(p + 4) = acc[ai][0][m][1]; }
    }
};

struct EpiY {
    static constexpr bool MID = false, PRE = false;
    const bf16_t* apr; const float* dskip; bf16_t* ys;
    __device__ __forceinline__ void operator()(AccRef acc, const Unit& u, int wr, int wc, int fr, int fq) const {
        const int colt = wc * 32 + fq * 8, row0 = u.pm * BM + wr * 64 + fr, g = u.z, ho = colt & 15;
        const f32x4 d0 = *(const f32x4*)(dskip + g * 16 + ho), d1 = *(const f32x4*)(dskip + g * 16 + ho + 4);
        u32x4 uu[2][4][2];
        FOR_AM { FOR_BJ uu[ai][m][bj] = *(const u32x4*)(apr + ((size_t)(g * 1024 + row0 + ai * HALF + m * 16)) * 384 + bj * HALF + colt); }
        FOR_AM { const int n = row0 + ai * HALF + m * 16;
            FOR_BJ { const int col = bj * HALF + colt;
                f32x4 u0, u1; unpack8(uu[ai][m][bj], u0, u1);
                f32x4 y0 = acc[ai][bj][m][0] + d0 * u0, y1 = acc[ai][bj][m][1] + d1 * u1;
#pragma unroll
                for (int j = 0; j < 4; ++j) { const float a = y0[j], b = y1[j];
                    y0[j] = a * fast_sigmoid(1.5957691216f * (a + 0.044715f * a * a * a)); y1[j] = b * fast_sigmoid(1.5957691216f * (b + 0.044715f * b * b * b)); }
                *(u32x4*)(ys + ((size_t)g * T_ + (size_t)n * 16) * 16 + col) = pack8(y0, y1); } }
    }
};

struct EpiGlu {
    static constexpr bool MID = false, PRE = false;
    const bf16_t* ys; const float* bglu; bf16_t* mrg; float* ssq_out;
    __device__ __forceinline__ void operator()(AccRef acc, const Unit& u, int wr, int wc, int fr, int fq) const {
        const int L_ = lane_fresh(), i16 = (L_ ^ 16) << 2, i32 = (L_ ^ 32) << 2;
        const int colt = wc * 32 + fq * 8, row0 = u.pm * BM + wr * 64 + fr;
        f32x4 bb[2][2];
        FOR_BJ { const int gc = u.pn * BM + bj * HALF + colt; bb[bj][0] = *(const f32x4*)(bglu + gc); bb[bj][1] = *(const f32x4*)(bglu + gc + 4); }
        u32x4 yy[2][4][2];
        FOR_AM { FOR_BJ { const int gc = u.pn * BM + bj * HALF + colt; yy[ai][m][bj] = *(const u32x4*)(ys + ((size_t)(gc >> 4) * T_ + row0 + ai * HALF + m * 16) * 16 + (gc & 15)); } }
        float ssv[2][4];
        FOR_AM { const int row = row0 + ai * HALF + m * 16; float ss = 0.f;
            FOR_BJ { const int gc = u.pn * BM + bj * HALF + colt;
                f32x4 y0, y1; unpack8(yy[ai][m][bj], y0, y1);
                f32x4 o0, o1;
#pragma unroll
                for (int j = 0; j < 4; ++j) { o0[j] = y0[j] * fast_sigmoid(acc[ai][bj][m][0][j] + bb[bj][0][j]); o1[j] = y1[j] * fast_sigmoid(acc[ai][bj][m][1][j] + bb[bj][1][j]); }
                *(u32x4*)(mrg + (size_t)row * D_ + gc) = pack8(o0, o1); ss += sumsq4(o0) + sumsq4(o1); }
            ss += xshfl(ss, i16); ss += xshfl(ss, i32); ssv[ai][m] = ss; }
        ATOMIC_ROWS(ssq_out, row0, fq, ssv);
    }
};

struct EpiPool {
    static constexpr bool MID = false, PRE = false;
    const float* pscale; bf16_t* mrg; float* ssq_out;
    __device__ __forceinline__ void operator()(AccRef acc, const Unit& u, int wr, int wc, int fr, int fq) const {
        const int L_ = lane_fresh(), i16 = (L_ ^ 16) << 2, i32 = (L_ ^ 32) << 2;
        const int colt = wc * 32 + fq * 8, row0 = u.pm * BM + wr * 64 + fr;
        f32x4 sc[2][2];
        FOR_BJ { const int pc = u.z * 256 + bj * HALF + colt; sc[bj][0] = *(const f32x4*)(pscale + pc); sc[bj][1] = *(const f32x4*)(pscale + pc + 4); }
        float ssv[2][4];
        FOR_AM { const int row = row0 + ai * HALF + m * 16; float ss = 0.f;
            FOR_BJ { const int pc = u.z * 256 + bj * HALF + colt;
                const f32x4 o0 = acc[ai][bj][m][0] * sc[bj][0], o1 = acc[ai][bj][m][1] * sc[bj][1];
                *(u32x4*)(mrg + (size_t)row * D_ + 1024 + pc) = pack8(o0, o1); ss += sumsq4(o0) + sumsq4(o1); }
            ss += xshfl(ss, i16); ss += xshfl(ss, i32); ssv[ai][m] = ss; }
        ATOMIC_ROWS(ssq_out, row0, fq, ssv);
    }
};

struct EpiSoftmax {
    static constexpr bool MID = false, PRE = false;
    const float* ssq; bf16_t* pm_; LAS float* red;
    __device__ __forceinline__ void operator()(AccRef acc, const Unit& u, int wr, int wc, int fr, int fq) const {
        const int L_ = lane_fresh(), i16 = (L_ ^ 16) << 2, i32 = (L_ ^ 32) << 2;
        const int colt = wc * 32 + fq * 8, rl0 = wr * 64 + fr, grow0 = (u.z >> 2) * 4096 + u.pm * BM, hd = u.z & 3;
        float sq[2][4];
        FOR_AM sq[ai][m] = ssq[grow0 + rl0 + ai * HALF + m * 16];
        FOR_AM { const float rs = rsqrtf(sq[ai][m] * (1.0f / D_) + EPS_); float v = -3.0e38f;
            FOR_BJ { acc[ai][bj][m][0] *= rs; acc[ai][bj][m][1] *= rs; v = fmaxf(v, fmaxf(max4(acc[ai][bj][m][0]), max4(acc[ai][bj][m][1]))); }
            v = fmaxf(v, xshfl(v, i16)); v = fmaxf(v, xshfl(v, i32));
            if (fq == 0) red[(rl0 + ai * HALF + m * 16) * 4 + wc] = v; }
        __syncthreads();
        FOR_AM { const f32x4 r4 = *(const LAS f32x4*)(red + (rl0 + ai * HALF + m * 16) * 4); const float mx = max4(r4); float s = 0.f;
            FOR_BJ {
#pragma unroll
                for (int n = 0; n < 2; ++n)
#pragma unroll
                    for (int j = 0; j < 4; ++j) { const float e = __expf(acc[ai][bj][m][n][j] - mx); acc[ai][bj][m][n][j] = e; s += e; } }
            s += xshfl(s, i16); s += xshfl(s, i32);
            if (fq == 0) red[1024 + (rl0 + ai * HALF + m * 16) * 4 + wc] = s; }
        __syncthreads();
        FOR_AM { const int rl = rl0 + ai * HALF + m * 16; const f32x4 r4 = *(const LAS f32x4*)(red + 1024 + rl * 4); const float inv = 1.0f / sum4(r4);
            FOR_BJ *(u32x4*)(pm_ + ((size_t)(grow0 + rl)) * 1024 + hd * 256 + bj * HALF + colt) = pack8(acc[ai][bj][m][0] * inv, acc[ai][bj][m][1] * inv); }
    }
};

struct EpiNull {
    static constexpr bool MID = false, PRE = false;
    float* sink;
    __device__ __forceinline__ void operator()(AccRef acc, const Unit& u, int wr, int wc, int fr, int fq) const {
        f32x4 s = {0.f, 0.f, 0.f, 0.f};
        FOR_AM { FOR_BJ { s += acc[ai][bj][m][0]; s += acc[ai][bj][m][1]; } }
        if (sum4(s) == 12345.678f) sink[fr] = 1.0f;
    }
};

__device__ __forceinline__ void tconv_tile(const int tid, LAS unsigned char* lds, const float* W, int N, int k0, int n0, const float* gA, const float* gB, int ksplit, bf16_t* out, int ldb, int mode, int rowbase) {
    LAS unsigned* tile = (LAS unsigned*)lds;
    f32x4 v[8];
#pragma unroll
    for (int it = 0; it < 8; ++it) v[it] = *(const f32x4*)(W + (size_t)(k0 + it * 8 + (tid >> 6)) * N + n0 + (tid & 63) * 4);
#pragma unroll
    for (int it = 0; it < 8; ++it) { const int k = it * 8 + (tid >> 6), kk = k0 + k; float g = 1.0f; if (gA) g = (kk < ksplit) ? gA[kk] : gB[kk - ksplit];
        tile[k * 129 + (tid & 63) * 2] = cvt_pk_bf16(v[it][0] * g, v[it][1] * g); tile[k * 129 + (tid & 63) * 2 + 1] = cvt_pk_bf16(v[it][2] * g, v[it][3] * g); }
    __syncthreads();
    const LAS bf16_t* t16 = (const LAS bf16_t*)lds;
#pragma unroll
    for (int it = 0; it < 4; ++it) { const int c = it * 512 + tid, n = c >> 3, kc = c & 7; unsigned e[8];
#pragma unroll
        for (int i = 0; i < 8; ++i) e[i] = t16[(kc * 8 + i) * 258 + n];
        u32x4 w; w.x = e[0] | (e[1] << 16); w.y = e[2] | (e[3] << 16); w.z = e[4] | (e[5] << 16); w.w = e[6] | (e[7] << 16);
        const int nn = n0 + n; const int ro = mode ? ((nn >> 7) * 256 + (nn & 127) + rowbase) : (nn + rowbase);
        *(u32x4*)(out + (size_t)ro * ldb + k0 + kc * 8) = w; }
    __syncthreads();
}

__device__ __forceinline__ void rows_to_bf16_ssq(const int tid, const float* src, bf16_t* dst, float* ssq, int nrows) {
    const int lane = tid & 63, gw = blockIdx.x * 8 + (tid >> 6), nw = gridDim.x * 8;
    for (int row = gw; row < nrows; row += nw) { const f32x4* p = (const f32x4*)(src + (size_t)row * D_); u32x2* q = (u32x2*)(dst + (size_t)row * D_); float ss = 0.f;
        f32x4 v[8];
#pragma unroll
        for (int i = 0; i < 8; ++i) v[i] = p[lane + 64 * i];
#pragma unroll
        for (int i = 0; i < 8; ++i) { ss += sumsq4(v[i]); u32x2 w; w.x = cvt_pk_bf16(v[i][0], v[i][1]); w.y = cvt_pk_bf16(v[i][2], v[i][3]); q[lane + 64 * i] = w; }
#pragma unroll
        for (int o = 32; o > 0; o >>= 1) ss += xshfl(ss, (lane ^ o) << 2);
        if (lane == 0) ssq[row] = ss; }
}


template <int W> __device__ __forceinline__ void pooled_w(const bf16_t* mrg, bf16_t* apool, const int gi, const int gt, const int nth) {
    for (int it = gt; it < T_ * 32; it += nth) { const int c = it & 31, t = it >> 5, ch = gi * 256 + c * 8, l = t & 4095;
        const bf16_t* src = mrg + (size_t)t * D_ + 1024 + ch; u32x4 r[W];
#pragma unroll
        for (int d = 0; d < W; ++d) { r[d] = (u32x4){0u, 0u, 0u, 0u}; if (d <= l) r[d] = *(const u32x4*)(src - (size_t)d * D_); }
        f32x4 c0, c1; unpack8(r[0], c0, c1); f32x4 s0 = c0, s1 = c1;
#pragma unroll
        for (int d = 1; d < W; ++d) { f32x4 a0, a1; unpack8(r[d], a0, a1); s0 += a0; s1 += a1; }
        const int cnt = (l + 1 < W) ? (l + 1) : W; const float ic = 1.0f / (float)cnt;
        *(u32x4*)(apool + (size_t)t * 1024 + ch) = pack8(s0 * ic - c0, s1 * ic - c1); }
}

#define W1GU ((bf16_t*)(P.ws + WS_W1GU))
#define W1D ((bf16_t*)(P.ws + WS_W1D))
#define W2GU ((bf16_t*)(P.ws + WS_W2GU))
#define W2D ((bf16_t*)(P.ws + WS_W2D))
#define WIN ((bf16_t*)(P.ws + WS_WIN))
#define WOUT ((bf16_t*)(P.ws + WS_WOUT))
#define WQ ((bf16_t*)(P.ws + WS_WQ))
#define WO ((bf16_t*)(P.ws + WS_WO))
#define WKV ((bf16_t*)(P.ws + WS_WKV))
#define WGLU ((bf16_t*)(P.ws + WS_WGLU))
#define WP ((bf16_t*)(P.ws + WS_WP))
#define PMAT ((bf16_t*)(P.ws + WS_PMAT))
#define TQ ((bf16_t*)(P.ws + WS_TQ))
#define APOW ((float2*)(P.ws + WS_APOW))
#define BBAR ((float2*)(P.ws + WS_BBAR))
#define KM ((float*)(P.ws + WS_KM))
#define MEMB ((bf16_t*)(P.ws + WS_MEMB))
#define KMAT ((bf16_t*)(P.ws + WS_KMAT))
#define VT ((bf16_t*)(P.ws + WS_VT))
#define HB ((bf16_t*)(P.ws + WS_HB))
#define SSQ ((float*)(P.ws + WS_SSQ))
#define ACT ((bf16_t*)((P.ws + WS_X) + X_ACT))
#define APR ((bf16_t*)((P.ws + WS_X) + X_APR))
#define MRG ((bf16_t*)((P.ws + WS_X) + X_MRG))
#define APOOL ((bf16_t*)((P.ws + WS_X) + X_APOOL))
#define YS ((bf16_t*)((P.ws + WS_X) + X_YS))
#define SLOC ((float*)((P.ws + WS_X) + X_SLOC))
#define MT ((bf16_t*)(P.ws + WS_MT))
#define VWT ((bf16_t*)(P.ws + WS_VWT))
#define PMb ((bf16_t*)((P.ws + WS_X) + X_P))
#define ssq_x (SSQ + 0 * T_)
#define ssq_mem (SSQ + 1 * T_)
#define ssq1 (SSQ + 2 * T_)
#define ssq_ssm (SSQ + 3 * T_)
#define ssq_pool (SSQ + 4 * T_)
#define ssq2 (SSQ + 5 * T_)
#define ssq3 (SSQ + 6 * T_)
#define ssq4 (SSQ + 7 * T_)
#define HF (P.out)

__device__ __forceinline__ void tconv_job(const Params& P, const int tid, LAS unsigned char* lds, const int tI) {
    int id = tI; const float* W; int K, N, ldb, mode = 0, rowbase = 0, ksplit; const float* gA = nullptr; const float* gB = nullptr; bf16_t* out;
    if (id < 4224) { const int j = id / 704; id -= j * 704; const int l = j / 3, r = j % 3;
        if (r < 2) { W = P.in[l ? (30 + r) : (3 + r)]; K = D_; N = FF_; out = l ? W2GU : W1GU; ldb = D_; mode = 1; rowbase = r * 128; gA = P.in[l ? 29 : 2]; }
        else { W = P.in[l ? 32 : 5]; K = FF_; N = D_; out = l ? W2D : W1D; ldb = FF_; } }
    else if (id < 4224 + 1536) { id -= 4224; const int j = id >> 8; id &= 255; K = D_; N = D_; ldb = D_;
        if (j == 0) { W = P.in[7]; out = WIN; gA = P.in[6]; }
        else if (j == 1) { W = P.in[22]; out = WOUT; gA = P.in[20]; gB = P.in[21]; }
        else if (j == 2) { return; }
        else if (j == 3) { W = P.in[26]; out = WKV; gA = P.in[24]; }
        else if (j == 4) { W = P.in[27]; out = WKV + (size_t)D_ * D_; gA = P.in[24]; }
        else { W = P.in[28]; out = WO; } }
    else if (id < 4224 + 1536 + 64) { id -= 4224 + 1536; W = P.in[16]; K = 1024; N = 1024; ldb = 1024; out = WGLU; }
    else { id -= 4224 + 1536 + 64; const int gi = id >> 2; id &= 3; W = P.in[18] + (size_t)gi * 65536; K = 256; N = 256; ldb = 256; out = WP + (size_t)gi * 65536; }
    ksplit = gB ? 1024 : K;
    const int nkt = K / 64; const int kt = id % nkt, ntile = id / nkt;
    tconv_tile(tid, lds, W, N, kt * 64, ntile * 256, gA, gB, ksplit, out, ldb, mode, rowbase);
}

__global__ void __launch_bounds__(512, 2) mega(Params P) {
    extern __shared__ __attribute__((aligned(16))) unsigned char lds_raw[];
    LAS unsigned char* lds = (LAS unsigned char*)lds_raw;
    cg::grid_group grid = cg::this_grid();
    const int G = gridDim.x, bx = blockIdx.x, nth = G * 512;
    const int wid_s = __builtin_amdgcn_readfirstlane(threadIdx.x >> 6);
#define PHASE_TID const int tid = opq_tid(wid_s); const int gt = bx * 512 + tid; (void)gt
    const float* x = P.in[0];

    Order S{}; S.G = G; S.c = bx;
    unsigned* BAR = (unsigned*)(P.ws + WS_BAR);
    volatile LAS unsigned* bst = (volatile LAS unsigned*)(lds + STAGE_BYTES + 8192);
    { const int t0 = opq_tid(wid_s); if (t0 < 2) bst[t0] = 0u;
      if (bx == 0) { for (int i = t0; i < XCD_BAR_WORDS; i += 512) BAR[i] = 0u; } }

#pragma unroll 1
    for (int pass = 0; pass < P.two; ++pass) {
        PHASE_TID;
        const int nkv = (G >= 128) ? 64 : 0;
        int start, stride, hi;
        const int nt_kv = 0;
        if (pass == 0) { start = 4224 + bx; stride = G; hi = 5840; } else if (bx >= nkv) { start = bx - nkv; stride = G - nkv; hi = 4224 - nt_kv; } else { start = 4224 - nt_kv + bx; stride = nkv; hi = 4224; }
        for (int tI = start; tI < hi; tI += stride) tconv_job(P, tid, lds, tI);
        if (pass == 0) {
            rows_to_bf16_ssq(tid, x, HB, ssq_x, T_);
            rows_to_bf16_ssq(tid, P.in[1], MEMB, ssq_mem, 1024);
            for (int i = gt; i < 6 * T_; i += nth) ssq1[i] = 0.f;
            for (int i = gt; i < D_ * D_ / 8; i += nth) { const int c = i >> 8; const float g = P.in[23][c]; const f32x4 a = *(const f32x4*)(P.in[25] + (size_t)i * 8), b = *(const f32x4*)(P.in[25] + (size_t)i * 8 + 4);
                *(u32x4*)(WQ + (size_t)i * 8) = pack8(a * g, b * g); }
            for (int item = gt; item < 4096 * 17; item += nth) {
                const int idx = item / 17, k = item - idx * 17, g = idx >> 6; const double dt = exp((double)P.in[10][g]); const float lr = P.in[8][idx], li = P.in[9][idx];
                const double xk = (double)lr * dt * k; double rev = (double)li * dt * k * 0.15915494309189535; rev -= rint(rev);
                const float a = (float)(rev * 6.283185307179586), xf = (float)xk; const float mag = expf(xf), cs = cosf(a), sn = sinf(a);
                APOW[item] = make_float2(mag * cs, mag * sn);
                if (k == 1) { const float a1i = mag * sn; const float sh = sinf(0.5f * a); const float nr1 = expm1f(xf) * cs - 2.0f * sh * sh;
                    const float den = lr * lr + li * li, fr_ = (nr1 * lr + a1i * li) / den, fi_ = (a1i * lr - nr1 * li) / den;
#pragma unroll 4
                    for (int h = 0; h < 16; ++h) { const float br = P.in[11][idx * 16 + h], bi = P.in[12][idx * 16 + h]; BBAR[idx * 16 + h] = make_float2(fr_ * br - fi_ * bi, fr_ * bi + fi_ * br); } }
            }
            grid.sync();
            (void)xcd_barrier_post(opq_tid(wid_s), BAR, bst);
        } else {
            if (bx < nkv || nkv == 0) {
                Order SK{}; SK.G = nkv ? nkv : G; SK.c = bx; SK.A = (const char*)MEMB; SK.B = (const char*)WKV; SK.tA = SK.tB = (size_t)BM * D_ * 2; SK.nM = 4; SK.nN = 16; SK.nZ = 1;
                EpiKV E{ssq_mem, KMAT, VT};
                gemm_phase(wid_s, lds, D_, D_, D_, false, SK, E);
            }
            xcd_barrier(wid_s, (unsigned*)(P.ws + WS_BAR), (volatile LAS unsigned*)(lds + STAGE_BYTES + 8192));
        }
    }
    if (PROBE == 3) { for (int r = 0; r < 10; ++r) xcd_barrier(wid_s, (unsigned*)(P.ws + WS_BAR), (volatile LAS unsigned*)(lds + STAGE_BYTES + 8192)); }
    {
        PHASE_TID;
        const float* c_re = P.in[13]; const float* c_im = P.in[14];
        for (int it = gt; it < 64 * 16 * 256; it += nth) { const int hi = it & 15, ho = (it >> 4) & 15, dl = (it >> 8) & 15, g = it >> 12; float s = 0.f;
#pragma unroll 16
            for (int p = 0; p < 64; ++p) { const float2 a = APOW[(g * 64 + p) * 17 + dl], b = BBAR[(g * 64 + p) * 16 + hi]; const float wr_ = a.x * b.x - a.y * b.y, wi_ = a.x * b.y + a.y * b.x;
                s += c_re[(g * 16 + ho) * 64 + p] * wr_ - c_im[(g * 16 + ho) * 64 + p] * wi_; }
            KM[it] = s; }
        for (int it = gt; it < 64 * 128 * 32; it += nth) { const int kc = it & 31, row = (it >> 5) & 127, g = it >> 12, p = row & 63, im = row >> 6, tau = kc >> 1, h0 = (kc & 1) * 8;
            const float2 a = APOW[(g * 64 + p) * 17 + 15 - tau]; f32x4 v0, v1;
#pragma unroll
            for (int e = 0; e < 8; ++e) { const float2 b = BBAR[(g * 64 + p) * 16 + h0 + e]; const float v = im ? (a.x * b.y + a.y * b.x) : (a.x * b.x - a.y * b.y); if (e < 4) v0[e] = v; else v1[e - 4] = v; }
            *(u32x4*)(PMAT + ((size_t)(g * 128 + row)) * 256 + kc * 8) = pack8(v0, v1); }
        for (int it = gt; it < 64 * 256 * 16; it += nth) { const int pc = it & 15, r = (it >> 4) & 255, g = it >> 12, tp = r >> 4, ho = r & 15, im = pc >> 3, p0 = (pc & 7) * 8; f32x4 v0, v1;
#pragma unroll
            for (int e = 0; e < 8; ++e) { const int p = p0 + e; const float2 a = APOW[(g * 64 + p) * 17 + tp + 1]; const float cr = c_re[(g * 16 + ho) * 64 + p], ci = c_im[(g * 16 + ho) * 64 + p];
                const float v = im ? -(cr * a.y + ci * a.x) : (cr * a.x - ci * a.y); if (e < 4) v0[e] = v; else v1[e - 4] = v; }
            *(u32x4*)(TQ + ((size_t)(g * 256 + r)) * 384 + 256 + pc * 8) = pack8(v0, v1); }
        __syncthreads();
        {
            const bool split = (G >= 256);
            for (int job = 0; job < 2; ++job) {
                if (split && ((bx >= 128) != (job == 1))) continue;
                Order SA{}; SA.G = split ? 128 : G; SA.c = split ? (bx & 127) : bx; SA.zsh = 2; SA.nZ = 16;
                if (job == 0) { SA.A = (const char*)KMAT; SA.zAhi = (size_t)256 * D_ * 2; SA.zAlo = 1024; SA.tA = 0; SA.B = (const char*)WQ; SA.zBhi = 0; SA.zBlo = 1024; SA.tB = (size_t)BM * D_ * 2; SA.nM = 1; SA.nN = 8; }
                else { SA.A = (const char*)WO; SA.zAhi = 0; SA.zAlo = 1024; SA.tA = (size_t)BM * D_ * 2; SA.B = (const char*)VT; SA.zBhi = (size_t)256 * D_ * 2; SA.zBlo = 1024; SA.tB = 0; SA.nM = 8; SA.nN = 1; }
                EpiStore EA{job ? VWT : MT, job ? 1024 : D_, job ? 1.0f : 0.044194173824159216f, job};
                gemm_phase(wid_s, lds, D_, D_, 512, false, SA, EA);
            }
        }
        S.A = (const char*)HB; S.B = (const char*)W1GU; S.zAhi = S.zAlo = S.zBhi = S.zBlo = 0; S.tA = (size_t)BM * D_ * 2; S.tB = (size_t)BM * D_ * 2; S.nM = 64; S.nN = 44; S.nZ = 1; S.zsh = 0; S.remap = 1;
        EpiGateUp E{ssq_x, ACT, (LAS float*)(lds + STAGE_BYTES)};
        gemm_phase(wid_s, lds, D_, D_, D_, false, S, E);
    }
    xcd_barrier(wid_s, (unsigned*)(P.ws + WS_BAR), (volatile LAS unsigned*)(lds + STAGE_BYTES + 8192));

    {
        PHASE_TID;
        for (int it = gt; it < 64 * 256 * 32; it += nth) { const int kc = it & 31, r = (it >> 5) & 255, g = it >> 13, tau = kc >> 1, hi0 = (kc & 1) * 8, tp = r >> 4, ho = r & 15;
            f32x4 v0 = {0.f, 0.f, 0.f, 0.f}, v1 = {0.f, 0.f, 0.f, 0.f};
            if (tp >= tau) { const float* kp = KM + ((g * 16 + tp - tau) * 16 + ho) * 16 + hi0; v0 = *(const f32x4*)kp; v1 = *(const f32x4*)(kp + 4); }
            *(u32x4*)(TQ + ((size_t)(g * 256 + r)) * 384 + kc * 8) = pack8(v0, v1); }
        __syncthreads();
        S.A = (const char*)ACT; S.B = (const char*)W1D; S.tA = (size_t)BM * FF_ * 2; S.tB = (size_t)BM * FF_ * 2; S.nM = 64; S.nN = 8; S.nZ = 1; S.remap = 1;
        EpiResid E{HB, ssq1, 0.5f};
        gemm_phase(wid_s, lds, FF_, FF_, FF_, false, S, E);
    }
    xcd_barrier(wid_s, (unsigned*)(P.ws + WS_BAR), (volatile LAS unsigned*)(lds + STAGE_BYTES + 8192));

    {
        S.A = (const char*)HB; S.B = (const char*)WIN; S.tA = S.tB = (size_t)BM * D_ * 2; S.nM = 64; S.nN = 8;
        EpiWin E{ssq1, APR, MRG, (LAS float*)(lds + STAGE_BYTES)};
        gemm_phase(wid_s, lds, D_, D_, D_, false, S, E);
    }
    xcd_barrier(wid_s, (unsigned*)(P.ws + WS_BAR), (volatile LAS unsigned*)(lds + STAGE_BYTES + 8192));

    {
        S.A = (const char*)APR; S.B = (const char*)PMAT; S.zAhi = (size_t)1024 * 384 * 2; S.zBhi = (size_t)128 * 256 * 2; S.tA = (size_t)BM * 384 * 2; S.tB = 0; S.nM = 4; S.nN = 1; S.nZ = 64; S.remap = 0;
        EpiSloc E{SLOC};
        gemm_phase(wid_s, lds, 384, 256, 256, true, S, E);
        if (G == 256) { __builtin_amdgcn_fence(__ATOMIC_ACQUIRE, "agent"); asm volatile("s_waitcnt vmcnt(0)" ::: "memory"); __syncthreads(); }
        else xcd_barrier(wid_s, (unsigned*)(P.ws + WS_BAR), (volatile LAS unsigned*)(lds + STAGE_BYTES + 8192));
        PHASE_TID;
        const int wid = tid >> 6, p = tid & 63; LAS float* endst = (LAS float*)(lds + STAGE_BYTES);
        for (int pair = bx; pair < 256; pair += G) { const int b = pair & 3, g = pair >> 2;
            const float2 a = APOW[(g * 64 + p) * 17 + 16];
            const float* sl = SLOC + ((size_t)(g * 1024 + b * 256 + wid * 32)) * 128;
            float xr[32], xi[32];
#pragma unroll
            for (int k = 0; k < 32; ++k) { xr[k] = sl[k * 128 + p]; xi[k] = sl[k * 128 + 64 + p]; }
            float sr = 0.f, si = 0.f;
#pragma unroll
            for (int k = 0; k < 32; ++k) { const float n_ = a.x * sr - a.y * si + xr[k]; si = a.x * si + a.y * sr + xi[k]; sr = n_; }
            float pr = a.x, pi = a.y;
#pragma unroll
            for (int q = 0; q < 5; ++q) { const float n_ = pr * pr - pi * pi; pi = 2.f * pr * pi; pr = n_; }
            endst[wid * 64 + p] = sr; endst[512 + wid * 64 + p] = si;
            __syncthreads();
            float cr = 0.f, ci = 0.f;
            for (int j = 0; j < wid; ++j) { const float ex = endst[j * 64 + p], ey = endst[512 + j * 64 + p]; const float n_ = pr * cr - pi * ci + ex; ci = pr * ci + pi * cr + ey; cr = n_; }
            bf16_t* ap = APR + ((size_t)(g * 1024 + b * 256 + wid * 32)) * 384 + 256;
            sr = cr; si = ci;
#pragma unroll
            for (int k = 0; k < 32; ++k) { const unsigned w = cvt_pk_bf16(sr, si); ap[k * 384 + p] = (bf16_t)(w & 0xffffu); ap[k * 384 + 64 + p] = (bf16_t)(w >> 16);
                const float n_ = a.x * sr - a.y * si + xr[k]; si = a.x * si + a.y * sr + xi[k]; sr = n_; }
            __syncthreads();
        }
        pooled_w<2>(MRG, APOOL, 0, gt, nth); pooled_w<4>(MRG, APOOL, 1, gt, nth); pooled_w<8>(MRG, APOOL, 2, gt, nth); pooled_w<16>(MRG, APOOL, 3, gt, nth);
    }
    xcd_barrier(wid_s, (unsigned*)(P.ws + WS_BAR), (volatile LAS unsigned*)(lds + STAGE_BYTES + 8192));

    {
        {
            S.A = (const char*)APR; S.B = (const char*)TQ; S.zAhi = (size_t)1024 * 384 * 2; S.zBhi = (size_t)256 * 384 * 2; S.tA = (size_t)BM * 384 * 2; S.tB = 0; S.nM = 4; S.nN = 1; S.nZ = 64; S.remap = 0;
            EpiY E{APR, P.in[15], YS};
            gemm_phase(wid_s, lds, 384, 384, 384, false, S, E);
        }
        {
            S.A = (const char*)APOOL; S.B = (const char*)WP; S.zAhi = 256 * 2; S.zBhi = (size_t)256 * 256 * 2; S.tA = (size_t)BM * 1024 * 2; S.tB = 0; S.nM = 64; S.nN = 1; S.nZ = 4; S.remap = 0;
            EpiPool E{P.in[19], MRG, ssq_pool};
            gemm_phase(wid_s, lds, 1024, 256, 256, false, S, E);
        }
    }
    xcd_barrier(wid_s, (unsigned*)(P.ws + WS_BAR), (volatile LAS unsigned*)(lds + STAGE_BYTES + 8192));

    {
        S.A = (const char*)YS; S.B = (const char*)WGLU; S.zAhi = S.zBhi = 0; S.tA = (size_t)BM * 32; S.tB = (size_t)BM * 1024 * 2; S.nM = 64; S.nN = 4; S.nZ = 1; S.remap = 1;
        EpiGlu E{YS, P.in[17], MRG, ssq_ssm};
        gemm_phase(wid_s, lds, 1024, 1024, 1024, false, S, E, true);
    }
    xcd_barrier(wid_s, (unsigned*)(P.ws + WS_BAR), (volatile LAS unsigned*)(lds + STAGE_BYTES + 8192));

    {
        const bool fuse2 = (512 % G) == 0;
        const int ncall = fuse2 ? 1 : P.two;
#pragma unroll 1
        for (int zz = 0; zz < ncall; ++zz) {
            S.A = (const char*)(MRG + (fuse2 ? 0 : zz * 1024)); S.B = (const char*)(WOUT + (fuse2 ? 0 : zz * 1024)); S.tA = S.tB = (size_t)BM * D_ * 2; S.nM = 64; S.nN = 8;
            S.nZ = fuse2 ? 2 : 1; S.zsh = 0; S.zAhi = 1024 * 2; S.zBhi = 1024 * 2; S.zAlo = S.zBlo = 0; S.remap = 1;
            EpiResid2 E{HB, ssq2, ssq_ssm, ssq_pool, fuse2 ? 0 : zz};
            gemm_phase(wid_s, lds, D_, D_, 1024, false, S, E);
            if (!fuse2 && zz == 0) xcd_barrier(wid_s, (unsigned*)(P.ws + WS_BAR), (volatile LAS unsigned*)(lds + STAGE_BYTES + 8192));
        }
        S.nZ = 1; S.zAhi = S.zBhi = 0;
    }
    xcd_barrier(wid_s, (unsigned*)(P.ws + WS_BAR), (volatile LAS unsigned*)(lds + STAGE_BYTES + 8192));

    {
        S.A = (const char*)HB; S.B = (const char*)MT; S.zsh = 2; S.zAhi = (size_t)4096 * D_ * 2; S.zAlo = 0; S.zBhi = (size_t)4 * 256 * D_ * 2; S.zBlo = (size_t)256 * D_ * 2; S.tA = (size_t)BM * D_ * 2; S.tB = 0; S.nM = 16; S.nN = 1; S.nZ = 16; S.remap = 0;
        EpiSoftmax E{ssq2, PMb, (LAS float*)(lds + STAGE_BYTES)};
        gemm_phase(wid_s, lds, D_, D_, D_, false, S, E);
    }
    xcd_barrier(wid_s, (unsigned*)(P.ws + WS_BAR), (volatile LAS unsigned*)(lds + STAGE_BYTES + 8192));

    {
        S.A = (const char*)PMb; S.B = (const char*)VWT; S.zsh = 0; S.zAhi = S.zAlo = S.zBhi = S.zBlo = 0; S.tA = (size_t)BM * 1024 * 2; S.tB = (size_t)BM * 1024 * 2; S.nM = 64; S.nN = 8; S.nZ = 1; S.remap = 1; S.bsh = 4; S.bstep = (size_t)2048 * 1024 * 2;
        EpiResid E{HB, ssq3, 1.0f};
        gemm_phase(wid_s, lds, 1024, 1024, 1024, false, S, E);
        S.bstep = 0; S.bsh = 0;
    }
    xcd_barrier(wid_s, (unsigned*)(P.ws + WS_BAR), (volatile LAS unsigned*)(lds + STAGE_BYTES + 8192));

    {
        S.A = (const char*)HB; S.B = (const char*)W2GU; S.tA = S.tB = (size_t)BM * D_ * 2; S.nM = 64; S.nN = 44;
        EpiGateUp E{ssq3, ACT, (LAS float*)(lds + STAGE_BYTES)};
        gemm_phase(wid_s, lds, D_, D_, D_, false, S, E);
        if (PROBE == 1) { xcd_barrier(wid_s, (unsigned*)(P.ws + WS_BAR), (volatile LAS unsigned*)(lds + STAGE_BYTES + 8192)); gemm_phase(wid_s, lds, D_, D_, D_, false, S, E); }
        if (PROBE == 5) {
            f32x4 pacc[32]; bf16x8 pa, pb;
#pragma unroll
            for (int i = 0; i < 32; ++i) pacc[i] = (f32x4){0.f, 0.f, 0.f, 0.f};
            { const int t9 = opq_tid(wid_s); const short v9 = (short)(0x3c00 + (t9 & 127));
#pragma unroll
              for (int i = 0; i < 8; ++i) { pa[i] = (short)(v9 + i * 3); pb[i] = (short)(v9 ^ (i * 5)); } }
#pragma unroll 1
            for (int it9 = 0; it9 < 11 * 32; ++it9) {
                __builtin_amdgcn_s_setprio(1);
#pragma unroll
                for (int r9 = 0; r9 < 2; ++r9)
#pragma unroll
                    for (int i = 0; i < 32; ++i) pacc[i] = __builtin_amdgcn_mfma_f32_16x16x32_bf16(pa, pb, pacc[i], 0, 0, 0);
                __builtin_amdgcn_s_setprio(0);
            }
            f32x4 s9 = {0.f, 0.f, 0.f, 0.f};
#pragma unroll
            for (int i = 0; i < 32; ++i) s9 += pacc[i];
            if (sum4(s9) == 12345.678f) ((float*)(P.ws + WS_KM))[0] = 1.0f;
        }
        if (PROBE == 9) { xcd_barrier(wid_s, (unsigned*)(P.ws + WS_BAR), (volatile LAS unsigned*)(lds + STAGE_BYTES + 8192)); Order S9 = S; EpiNull E9{(float*)(P.ws + WS_KM)}; gemm_phase(wid_s, lds, D_, D_, D_, false, S9, E9); }
        if (PROBE == 7) { xcd_barrier(wid_s, (unsigned*)(P.ws + WS_BAR), (volatile LAS unsigned*)(lds + STAGE_BYTES + 8192)); Order S9 = S; S9.tA = S9.tB = (size_t)BM * (D_ + 64) * 2; EpiNull E9{(float*)(P.ws + WS_KM)}; gemm_phase(wid_s, lds, D_ + 64, D_ + 64, D_, false, S9, E9); }
    }
    xcd_barrier(wid_s, (unsigned*)(P.ws + WS_BAR), (volatile LAS unsigned*)(lds + STAGE_BYTES + 8192));

    {
        S.A = (const char*)ACT; S.B = (const char*)W2D; S.tA = S.tB = (size_t)BM * FF_ * 2; S.nM = 64; S.nN = 8;
        EpiResid E{HB, ssq4, 0.5f};
        gemm_phase(wid_s, lds, FF_, FF_, FF_, false, S, E);
    }
    xcd_barrier(wid_s, (unsigned*)(P.ws + WS_BAR), (volatile LAS unsigned*)(lds + STAGE_BYTES + 8192));

    {
        PHASE_TID;
        const int lane = tid & 63, gw = bx * 8 + (tid >> 6), nw = G * 8; const f32x4* gf = (const f32x4*)P.in[33];
        for (int row = gw; row < T_; row += 2 * nw) {
            const bool has2 = (row + nw < T_); const int row2 = has2 ? row + nw : row;
            const float rs = rsqrtf(ssq4[row] * (1.0f / D_) + EPS_), rs2 = rsqrtf(ssq4[row2] * (1.0f / D_) + EPS_);
            const u32x4* hp = (const u32x4*)(HB + (size_t)row * D_); const u32x4* hp2 = (const u32x4*)(HB + (size_t)row2 * D_);
            f32x4* p = (f32x4*)(P.out + (size_t)row * D_); f32x4* p2 = (f32x4*)(P.out + (size_t)row2 * D_);
            u32x4 w[4], w2[4];
#pragma unroll
            for (int i = 0; i < 4; ++i) { w[i] = hp[lane + 64 * i]; w2[i] = hp2[lane + 64 * i]; }
#pragma unroll
            for (int i = 0; i < 4; ++i) { f32x4 a, b; const int c4 = (lane + 64 * i) * 2; const f32x4 g0 = gf[c4], g1 = gf[c4 + 1];
                unpack8(w[i], a, b); p[c4] = a * rs * g0; p[c4 + 1] = b * rs * g1;
                unpack8(w2[i], a, b); if (has2) { p2[c4] = a * rs2 * g0; p2[c4 + 1] = b * rs2 * g1; } } }
    }
}

extern "C" void kernel_launch(void* const* d_in, const int* in_sizes, int n_in, void* d_out, int out_size, void* d_ws, size_t ws_size, hipStream_t stream) {
    static int grid_blocks = 0;
    if (!grid_blocks) {
        if (n_in != 34 || out_size != T_ * D_ || ws_size < WS_END) { fprintf(stderr, "kernel_launch: unexpected shapes (n_in %d out %d ws %zu need %zu)\n", n_in, out_size, ws_size, (size_t)WS_END); grid_blocks = -1; return; }
        int dev = 0, cus = 0, per_cu = 0;
        (void)hipGetDevice(&dev);
        (void)hipDeviceGetAttribute(&cus, hipDeviceAttributeMultiprocessorCount, dev);
        if (hipFuncSetAttribute((const void*)mega, hipFuncAttributeMaxDynamicSharedMemorySize, LDS_BYTES) != hipSuccess) { fprintf(stderr, "hipFuncSetAttribute failed\n"); grid_blocks = -1; return; }
        (void)hipOccupancyMaxActiveBlocksPerMultiprocessor(&per_cu, (const void*)mega, 512, LDS_BYTES);
        if (per_cu < 1) per_cu = 1;
        grid_blocks = cus * per_cu;
    }
    if (grid_blocks < 0) return;
    Params p{};
    for (int i = 0; i < 34; ++i) p.in[i] = (const float*)d_in[i];
    p.out = (float*)d_out; p.ws = (unsigned char*)d_ws; p.two = 2; p.pad = 0;
    void* args[] = {&p};
    hipError_t e = hipLaunchCooperativeKernel((const void*)mega, dim3(grid_blocks), dim3(512), args, LDS_BYTES, stream);
    if (e != hipSuccess) fprintf(stderr, "cooperative launch failed: %s (grid %d)\n", hipGetErrorString(e), grid_blocks);
}
```
